# Optimizing an MI355X kernel written in HIP

```python
import jax, jax.numpy as jnp
from jax import lax
import numpy as np

D_MODEL = 1024
BATCH = 4
SEQ = 8192
DEPTH = 1

CHUNK = 64
Q_BLOCK = 128
SB_HEADS = 8
SB_HEAD_DIM = D_MODEL // SB_HEADS
SB_WIDTH = SB_HEADS * SB_HEAD_DIM
RET_HEADS = 4
RET_KEY_DIM = D_MODEL // RET_HEADS
RET_VAL_DIM = D_MODEL // RET_HEADS
RET_QK_WIDTH = RET_HEADS * RET_KEY_DIM
RET_WIDTH = RET_HEADS * RET_VAL_DIM
ROPE_BASE = 10000.0
EPS = 1e-6
SPLIT_SIZES = (SB_WIDTH, SB_WIDTH, SB_WIDTH, SB_WIDTH,
               RET_QK_WIDTH, RET_QK_WIDTH, RET_WIDTH, RET_WIDTH,
               D_MODEL, D_MODEL)
IN_COLS = sum(SPLIT_SIZES)
SPLIT_POINTS = tuple(int(v) for v in np.cumsum(SPLIT_SIZES)[:-1])

kernel_name = "hybrid_stickbreak_retention_gated_block"


def rms_norm(x, gain):
    xf = x.astype(jnp.float32)
    y = xf * lax.rsqrt(jnp.mean(xf * xf, axis=-1, keepdims=True) + EPS)
    return (y * gain.astype(jnp.float32)).astype(x.dtype)


def split_heads(t, n_heads):
    b, s, w = t.shape
    return t.reshape(b, s, n_heads, w // n_heads).transpose(0, 2, 1, 3)


def merge_heads(t):
    b, h, s, d = t.shape
    return t.transpose(0, 2, 1, 3).reshape(b, s, h * d)


def rotary(t):
    s, d = t.shape[2], t.shape[3]
    inv_freq = ROPE_BASE ** (-jnp.arange(0, d, 2, dtype=jnp.float32) / d)
    ang = jnp.arange(s, dtype=jnp.float32)[:, None] * inv_freq[None, :]
    cos, sin = jnp.cos(ang), jnp.sin(ang)
    tf = t.astype(jnp.float32)
    t1, t2 = tf[..., : d // 2], tf[..., d // 2:]
    out = jnp.concatenate([t1 * cos - t2 * sin, t1 * sin + t2 * cos], axis=-1)
    return out.astype(t.dtype)


def stick_breaking_attention(q, k, v):
    b, h, s, d = q.shape
    nb = s // Q_BLOCK
    qb = q.reshape(b, h, nb, Q_BLOCK, d).transpose(2, 0, 1, 3, 4)
    kpos = jnp.arange(s)
    scale = d ** -0.5

    def block(args):
        qi, i = args
        z = jnp.einsum('bhqd,bhkd->bhqk', qi, k).astype(jnp.float32) * scale
        qpos = i * Q_BLOCK + jnp.arange(Q_BLOCK)
        mask = kpos[None, :] < qpos[:, None]
        log_keep = jnp.where(mask, jax.nn.log_sigmoid(-z), 0.0)
        suffix = lax.cumsum(log_keep, axis=3, reverse=True) - log_keep
        w = jnp.where(mask, jnp.exp(jax.nn.log_sigmoid(z) + suffix), 0.0)
        return jnp.einsum('bhqk,bhkd->bhqd', w.astype(v.dtype), v)

    out = lax.map(block, (qb, jnp.arange(nb)))
    return out.transpose(1, 2, 0, 3, 4).reshape(b, h, s, d)


def chunkwise_retention(q, k, v):
    dtype = v.dtype
    q, k, v = (a.astype(jnp.float32) for a in (q, k, v))
    b, h, s, dk = q.shape
    dv = v.shape[-1]
    n = s // CHUNK
    log_gamma = jnp.log1p(-jnp.exp2(-5.0 - jnp.arange(h, dtype=jnp.float32)))
    qc = q.reshape(b, h, n, CHUNK, dk)
    kc = k.reshape(b, h, n, CHUNK, dk)
    vc = v.reshape(b, h, n, CHUNK, dv)
    idx = jnp.arange(CHUNK, dtype=jnp.float32)
    intra_decay = jnp.exp(log_gamma[:, None, None] * jnp.abs(idx[:, None] - idx[None, :]))
    scores = jnp.einsum('bhnqd,bhnkd->bhnqk', qc, kc) * intra_decay[None, :, None]
    intra = jnp.einsum('bhnqk,bhnke->bhnqe', scores, vc)
    q_decay = jnp.exp(log_gamma[:, None] * (idx + 1.0))[None, :, :, None]
    k_decay = jnp.exp(log_gamma[:, None] * (CHUNK - 1.0 - idx))[None, :, :, None]
    chunk_decay = jnp.exp(log_gamma * CHUNK)[None, :, None, None]

    def step(state, inp):
        qi, ki, vi = inp
        out = jnp.einsum('bhqd,bhde->bhqe', qi * q_decay, state)
        state = state * chunk_decay + jnp.einsum('bhkd,bhke->bhde', ki * k_decay, vi)
        return state, out

    init = jnp.zeros((b, h, dk, dv), jnp.float32)
    xs = (qc.transpose(2, 0, 1, 3, 4), kc.transpose(2, 0, 1, 3, 4), vc.transpose(2, 0, 1, 3, 4))
    _, inter = lax.scan(step, init, xs)
    out = intra + inter.transpose(1, 2, 0, 3, 4)
    return out.reshape(b, h, s, dv).astype(dtype)


def setup_inputs(seed: int = 0) -> dict:
    key = jax.random.key(seed)
    ks = jax.random.split(key, 10)
    f32 = jnp.float32
    x = jax.random.normal(ks[0], (BATCH, SEQ, D_MODEL), f32)
    norm_gain = 1.0 + 0.05 * jax.random.normal(ks[1], (DEPTH, D_MODEL), f32)
    w_in = jax.random.normal(ks[2], (DEPTH, D_MODEL, IN_COLS), f32) * D_MODEL ** -0.5
    b_merge = 0.01 * jax.random.normal(ks[3], (DEPTH, 2, D_MODEL), f32)
    sb_q_gain = 1.0 + 0.05 * jax.random.normal(ks[4], (DEPTH, SB_HEAD_DIM), f32)
    sb_k_gain = 1.0 + 0.05 * jax.random.normal(ks[5], (DEPTH, SB_HEAD_DIM), f32)
    ret_out_gain = 1.0 + 0.05 * jax.random.normal(ks[6], (DEPTH, RET_HEADS, RET_VAL_DIM), f32)
    w_branch_sb = jax.random.normal(ks[7], (DEPTH, SB_WIDTH, D_MODEL), f32) * SB_WIDTH ** -0.5
    w_branch_ret = jax.random.normal(ks[8], (DEPTH, RET_WIDTH, D_MODEL), f32) * RET_WIDTH ** -0.5
    w_out = jax.random.normal(ks[9], (DEPTH, D_MODEL, D_MODEL), f32) * D_MODEL ** -0.5
    return {"x": x, "norm_gain": norm_gain, "w_in": w_in, "b_merge": b_merge,
            "sb_q_gain": sb_q_gain, "sb_k_gain": sb_k_gain, "ret_out_gain": ret_out_gain,
            "w_branch_sb": w_branch_sb, "w_branch_ret": w_branch_ret, "w_out": w_out}


def reference(x, norm_gain, w_in, b_merge, sb_q_gain, sb_k_gain, ret_out_gain,
              w_branch_sb, w_branch_ret, w_out):
    for layer in range(DEPTH):
        h = rms_norm(x, norm_gain[layer])
        proj = jnp.einsum('bsd,dc->bsc', h, w_in[layer])
        (sb_q, sb_k, sb_v, sb_g, r_q, r_k, r_v, r_g, m_sb, m_ret) = jnp.split(proj, SPLIT_POINTS, axis=-1)

        qa = rms_norm(split_heads(sb_q, SB_HEADS), sb_q_gain[layer])
        ka = rms_norm(split_heads(sb_k, SB_HEADS), sb_k_gain[layer])
        va = split_heads(sb_v, SB_HEADS)
        out_a = merge_heads(stick_breaking_attention(qa, ka, va)) * jax.nn.silu(sb_g)

        qb = rotary(split_heads(r_q, RET_HEADS))
        kb = rotary(split_heads(r_k, RET_HEADS)) * (RET_KEY_DIM ** -0.5)
        vb = split_heads(r_v, RET_HEADS)
        ret = chunkwise_retention(qb, kb, vb)
        ret = rms_norm(ret, ret_out_gain[layer][None, :, None, :])
        out_b = merge_heads(ret) * jax.nn.silu(r_g)

        p_a = jnp.einsum('bsw,wd->bsd', out_a, w_branch_sb[layer])
        p_b = jnp.einsum('bsw,wd->bsd', out_b, w_branch_ret[layer])
        merged = (jax.nn.sigmoid(m_sb + b_merge[layer, 0]) * p_a
                  + jax.nn.sigmoid(m_ret + b_merge[layer, 1]) * p_b)
        x = x + jnp.einsum('bsd,de->bse', merged, w_out[layer])
    return x
```

```cpp
#include <hip/hip_runtime.h>
#include <cstdio>
#include <cstdint>

#define LAS __attribute__((address_space(3)))
#define GAS __attribute__((address_space(1)))
typedef unsigned short bf16_t;
typedef short bf16x8 __attribute__((ext_vector_type(8)));
typedef float f32x4 __attribute__((ext_vector_type(4)));
typedef float f32x2 __attribute__((ext_vector_type(2)));
typedef unsigned u32x4 __attribute__((ext_vector_type(4)));
typedef unsigned u32x2 __attribute__((ext_vector_type(2)));

constexpr int D = 1024, BATCH = 4, SEQ = 8192, NTOK = BATCH * SEQ;
constexpr int NPASS = 2, PTOK = NTOK / NPASS;
constexpr int INC = 10240;
constexpr int SBH = 8, SBD = 128, RH = 4, RD = 256;
constexpr float EPS = 1e-6f;
constexpr float QSCALE = 0.12751743082459868f;
constexpr float LN2F = 0.6931471805599453f;
constexpr size_t MiB = 1u << 20;
constexpr size_t WS_CTL = 0, CTL_ZERO_BYTES = 1 * MiB;
constexpr size_t WS_WIN = 1 * MiB, WS_WSB = 21 * MiB, WS_WRET = 23 * MiB, WS_WOUT = 25 * MiB, WS_TAB = 27 * MiB, WS_H = 35 * MiB;
constexpr size_t WS_PP = 99 * MiB;
constexpr size_t ARR = (size_t)PTOK * 1024 * 2;
constexpr size_t WS_T1 = WS_PP + 10 * ARR, WS_MG = WS_T1 + ARR, WS_END = WS_MG + ARR;
enum { A_QS = 0, A_KS, A_VS, A_GS, A_RQ, A_RK, A_RV, A_GR, A_MA, A_MB };
constexpr int CW_BAR = 4096;
constexpr int RING_BYTES = 131072, SCR_OFF = RING_BYTES, SCR_BYTES = 8192, MISC_OFF = SCR_OFF + SCR_BYTES, LDS_BYTES = 147456;
constexpr int NWAVES = 8;

__device__ const float INVF[128] = {
1.0f, 0.930572033f, 0.865964353f, 0.805842161f, 0.749894261f, 0.697830617f, 0.649381638f, 0.604296386f, 0.562341332f, 0.523299098f, 0.486967534f, 0.453158379f, 0.421696514f, 0.392418981f, 0.365174115f, 0.339820832f, 0.316227764f, 0.294272691f, 0.273841977f, 0.254829675f, 0.237137377f, 0.220673412f, 0.2053525f, 0.191095307f, 0.177827939f, 0.165481716f, 0.153992653f, 0.143301249f, 0.133352131f, 0.124093778f, 0.115478203f, 0.107460782f, 0.100000001f, 0.0930572078f, 0.0865964293f, 0.0805842131f, 0.0749894157f, 0.0697830617f, 0.0649381652f, 0.0604296401f, 0.0562341325f, 0.0523299128f, 0.0486967526f, 0.0453158356f, 0.0421696529f, 0.0392418951f, 0.0365174115f, 0.0339820832f, 0.0316227749f, 0.0294272713f, 0.0273841973f, 0.0254829675f, 0.0237137377f, 0.0220673401f, 0.0205352511f, 0.0191095285f, 0.0177827943f, 0.0165481698f, 0.0153992651f, 0.0143301254f, 0.0133352149f, 0.0124093778f, 0.0115478206f, 0.0107460786f, 0.00999999978f, 0.00930572022f, 0.00865964312f, 0.00805842225f, 0.00749894185f, 0.00697830599f, 0.00649381615f, 0.00604296383f, 0.00562341325f, 0.00523299119f, 0.00486967526f, 0.00453158328f, 0.00421696482f, 0.0039241896f, 0.00365174119f, 0.00339820841f, 0.00316227763f, 0.00294272718f, 0.00273841969f, 0.00254829694f, 0.00237137359f, 0.00220673415f, 0.00205352483f, 0.00191095297f, 0.00177827943f, 0.00165481714f, 0.00153992651f, 0.00143301254f, 0.00133352145f, 0.00124093774f, 0.0011547819f, 0.00107460783f, 0.00100000005f, 0.000930572045f, 0.000865964335f, 0.000805842166f, 0.000749894243f, 0.000697830576f, 0.000649381662f, 0.000604296394f, 0.000562341302f, 0.000523299095f, 0.000486967532f, 0.000453158369f, 0.000421696517f, 0.000392418966f, 0.000365174143f, 0.000339820836f, 0.000316227757f, 0.000294272701f, 0.000273841957f, 0.000254829676f, 0.00023713737f, 0.000220673406f, 0.00020535251f, 0.0001910953f, 0.00017782794f, 0.000165481717f, 0.000153992645f, 0.000143301251f, 0.00013335215f, 0.000124093771f, 0.0001154782f, 0.000107460786f };
__device__ __forceinline__ float log2gamma(int h) { return h == 0 ? -0.04580368961312479f : h == 1 ? -0.02272007650008353f : h == 2 ? -0.011315313227834146f : -0.005646563141142063f; }

__device__ __forceinline__ unsigned cvt_pk_bf16(float lo, float hi) { unsigned r; asm volatile("v_cvt_pk_bf16_f32 %0, %1, %2" : "=v"(r) : "v"(lo), "v"(hi)); return r; }
__device__ __forceinline__ float bf_lo(unsigned w) { return __uint_as_float(w << 16); }
__device__ __forceinline__ float bf_hi(unsigned w) { return __uint_as_float(w & 0xffff0000u); }
__device__ __forceinline__ float wave_sum(float v) {
#pragma unroll
    for (int o = 1; o < 64; o <<= 1) v += __shfl_xor(v, o);
    return v;
}
__device__ __forceinline__ float fast_sigmoid(float v) { return __builtin_amdgcn_rcpf(1.0f + __builtin_amdgcn_exp2f(-1.4426950408889634f * v)); }
#define LDS_WAIT() asm volatile("s_waitcnt lgkmcnt(0)" ::: "memory")
#define VM_WAIT() asm volatile("s_waitcnt vmcnt(0)" ::: "memory")

namespace pg8 {
constexpr int BM = 256, BK = 64, HALF = 128, HTB = HALF * BK * 2, STAGE_BYTES = 8 * HTB;
__host__ __device__ __forceinline__ int lds_byte(int r, int c) { const int st = (r >> 4) * 2 + (c >> 5), rr = r & 15, cc = c & 31, ob = rr * 64 + cc * 2; return st * 1024 + (ob ^ (((ob >> 9) & 1) << 5)); }
__host__ __device__ __forceinline__ void stage_rc(int b, int& R, int& C) { const int st = b / 1024, sb = b % 1024, swz = sb ^ (((sb >> 9) & 1) << 5); R = (st >> 1) * 16 + swz / 64; C = (st & 1) * 32 + (swz % 64) / 2; }
__host__ __device__ __forceinline__ int perm32(int rho) { const int n = rho >> 4, i = rho & 15; return 8 * (i >> 2) + 4 * n + (i & 3); }
struct Unit { int pm, pn; };

struct StaticOrder {
    int nM, nN, nwg, G, c; const char* A; const char* B; size_t tA, tB;
    __device__ void init(int M, int N, int G_, int c_, const void* A_, const void* B_, int lda, int ldb) { nM = M / BM; nN = N / BM; nwg = nM * nN; G = G_; c = c_; A = (const char*)A_; B = (const char*)B_; tA = (size_t)BM * lda * 2; tB = (size_t)BM * ldb * 2; }
    __device__ bool next(int i, Unit& u) const {
        const long L = (long)i * G + c; if (L >= nwg) return false;
        int wgid = (int)L; { const int q = nwg / 8, r = nwg % 8, xcd = wgid % 8, off = wgid / 8; wgid = (xcd < r ? xcd * (q + 1) : r * (q + 1) + (xcd - r) * q) + off; }
        const int nig = 8 * nN, gid = wgid / nig, fm = gid * 8, gsz = (nM - fm) < 8 ? (nM - fm) : 8;
        u.pm = fm + ((wgid % nig) % gsz); u.pn = (wgid % nig) / gsz; return true;
    }
    __device__ __forceinline__ void ptrs(const Unit& u, const char*& a, const char*& b) const { a = A + (size_t)u.pm * tA; b = B + (size_t)u.pn * tB; }
};

template <class Epi, class Sched>
__device__ __forceinline__ void gemm_phase(LAS unsigned char* lds, LAS unsigned char* scr, const int K, const int lda, const int ldb, const Sched& S, const Epi& E) {
    int tid = threadIdx.x; asm volatile("" : "+v"(tid));
    const int wid = __builtin_amdgcn_readfirstlane(tid >> 6), lane = tid & 63, wr = wid >> 2, wc = wid & 3, fr = lane & 15, fq = lane >> 4;
    const int nt = K / BK;
    unsigned voffA[2], voffB[2];
#pragma unroll
    for (int i = 0; i < 2; ++i) { int R, C; stage_rc(tid * 16 + i * 8192, R, C); const int Rb = (R & ~31) + perm32(R & 31);
        voffA[i] = (unsigned)(R * lda + C) * 2u; voffB[i] = (unsigned)(Rb * ldb + C) * 2u; }
    const size_t kstep = (size_t)(BK * 2);
    const size_t hstepA = (size_t)HALF * lda * 2, hstepB = (size_t)HALF * ldb * 2;
    const unsigned ldsw = (unsigned)wid * 1024u;
    const int aoff = lds_byte(wr * 64 + fr, fq * 8), boff = lds_byte(wc * 32 + fr, fq * 8);
#define PG8_SA(b, h) (((b) * 2 + (h)) * HTB)
#define PG8_SB(b, h) ((4 + (b) * 2 + (h)) * HTB)
#define PG8_STAGE(bufoff, gbase, voff) do { _Pragma("unroll") for (int _i = 0; _i < 2; ++_i) \
        __builtin_amdgcn_global_load_lds((const unsigned*)((const char*)(gbase) + (voff)[_i]), (LAS unsigned*)(lds + (bufoff) + ldsw + _i * 8192), 16, 0, 0); } while (0)
#define PG8_LDA(dst, b, h) do { _Pragma("unroll") for (int m = 0; m < 4; ++m) _Pragma("unroll") for (int k = 0; k < 2; ++k) dst[m][k] = *(const LAS bf16x8*)(lds + PG8_SA(b, h) + aoff + m * 2048 + k * 1024); } while (0)
#define PG8_LDB(dst, b, h) do { _Pragma("unroll") for (int n = 0; n < 2; ++n) _Pragma("unroll") for (int k = 0; k < 2; ++k) dst[n][k] = *(const LAS bf16x8*)(lds + PG8_SB(b, h) + boff + n * 2048 + k * 1024); } while (0)
#define PG8_MMA(ai, bj, At, Bt) do { __builtin_amdgcn_s_setprio(1); _Pragma("unroll") for (int m = 0; m < 4; ++m) _Pragma("unroll") for (int n = 0; n < 2; ++n) _Pragma("unroll") for (int k = 0; k < 2; ++k) \
        acc[ai][bj][m][n] = __builtin_amdgcn_mfma_f32_16x16x32_bf16(Bt[n][k], At[m][k], acc[ai][bj][m][n], 0, 0, 0); __builtin_amdgcn_s_setprio(0); } while (0)
#define PG8_WAIT_V(n) asm volatile("s_waitcnt vmcnt(" #n ")" ::: "memory")
#define PG8_WAIT_L(n) asm volatile("s_waitcnt lgkmcnt(" #n ")" ::: "memory")
#define PG8_BAR __builtin_amdgcn_s_barrier()
#define PG8_SCHED __builtin_amdgcn_sched_barrier(0)
    Unit cur, nxt; int ui = 0;
    if (!S.next(0, cur)) return;
    f32x4 acc[2][2][4][2];
#pragma unroll
    for (int a = 0; a < 2; ++a)
#pragma unroll
        for (int b = 0; b < 2; ++b)
#pragma unroll
            for (int m = 0; m < 4; ++m)
#pragma unroll
                for (int n = 0; n < 2; ++n) acc[a][b][m][n] = (f32x4){0.f, 0.f, 0.f, 0.f};
    bf16x8 At[4][2], B0[2][2], B1[2][2];
    const char* cA; const char* cB; S.ptrs(cur, cA, cB);
    PG8_STAGE(PG8_SB(0, 0), cB, voffB); PG8_STAGE(PG8_SB(0, 1), cB + hstepB, voffB); PG8_STAGE(PG8_SA(0, 0), cA, voffA); PG8_STAGE(PG8_SA(0, 1), cA + hstepA, voffA);
    if (wr == 1) PG8_BAR;
    PG8_WAIT_V(2); PG8_BAR;
    PG8_STAGE(PG8_SB(1, 0), cB + kstep, voffB); PG8_STAGE(PG8_SA(1, 0), cA + kstep, voffA); PG8_STAGE(PG8_SB(1, 1), cB + hstepB + kstep, voffB);
    PG8_WAIT_V(6); PG8_BAR;
    for (;;) {
        const bool has_next = S.next(ui + 1, nxt);
        const char* nA = cA; const char* nB = cB; if (has_next) S.ptrs(nxt, nA, nB);
        for (int t = 0; t < nt; t += 2) {
            const bool last = (t == nt - 2);
            const char* a1 = cA + (size_t)(t + 1) * kstep;
            const char* a2 = last ? nA : cA + (size_t)(t + 2) * kstep; const char* b2 = last ? nB : cB + (size_t)(t + 2) * kstep;
            const char* a3 = a2 + kstep; const char* b3 = b2 + kstep;
            PG8_LDB(B0, 0, 0); PG8_LDB(B1, 0, 1); PG8_SCHED; PG8_LDA(At, 0, 0); PG8_STAGE(PG8_SA(1, 1), a1 + hstepA, voffA);
            PG8_WAIT_V(8); PG8_WAIT_L(0); PG8_BAR; PG8_MMA(0, 0, At, B0); PG8_MMA(0, 1, At, B1); PG8_BAR; PG8_SCHED;
            PG8_LDA(At, 0, 1); PG8_STAGE(PG8_SB(0, 0), b2, voffB); PG8_STAGE(PG8_SB(0, 1), b2 + hstepB, voffB); PG8_STAGE(PG8_SA(0, 0), a2, voffA);
            PG8_WAIT_V(8); PG8_WAIT_L(0); PG8_BAR; PG8_MMA(1, 0, At, B0); PG8_MMA(1, 1, At, B1); PG8_BAR; PG8_SCHED;
            PG8_LDB(B0, 1, 0); PG8_LDB(B1, 1, 1); PG8_SCHED; PG8_LDA(At, 1, 0); PG8_STAGE(PG8_SA(0, 1), a2 + hstepA, voffA);
            PG8_WAIT_V(8); PG8_WAIT_L(0); PG8_BAR; PG8_MMA(0, 0, At, B0); PG8_MMA(0, 1, At, B1); PG8_BAR; PG8_SCHED;
            PG8_LDA(At, 1, 1); PG8_STAGE(PG8_SB(1, 0), b3, voffB); PG8_STAGE(PG8_SB(1, 1), b3 + hstepB, voffB); PG8_STAGE(PG8_SA(1, 0), a3, voffA);
            PG8_WAIT_V(8); PG8_WAIT_L(0); PG8_BAR; PG8_MMA(1, 0, At, B0); PG8_MMA(1, 1, At, B1); PG8_BAR; PG8_SCHED;
        }
        if (wr == 0) PG8_BAR;
        E(acc, cur, wr, wc, fr, fq, scr, wid, lane);
        if (!has_next) break;
#pragma unroll
        for (int a = 0; a < 2; ++a)
#pragma unroll
            for (int b = 0; b < 2; ++b)
#pragma unroll
                for (int m = 0; m < 4; ++m)
#pragma unroll
                    for (int n = 0; n < 2; ++n) acc[a][b][m][n] = (f32x4){0.f, 0.f, 0.f, 0.f};
        cur = nxt; cA = nA; cB = nB; ++ui;
        if (wr == 1) PG8_BAR;
    }
    PG8_WAIT_V(0);
    PG8_BAR;
#undef PG8_SA
#undef PG8_SB
#undef PG8_STAGE
#undef PG8_LDA
#undef PG8_LDB
#undef PG8_MMA
#undef PG8_WAIT_V
#undef PG8_WAIT_L
#undef PG8_BAR
#undef PG8_SCHED
}
}

typedef f32x4 AccT[2][2][4][2];
__device__ __forceinline__ void st8(bf16_t* p, const f32x4& v0, const f32x4& v1) {
    u32x4 w; w.x = cvt_pk_bf16(v0[0], v0[1]); w.y = cvt_pk_bf16(v0[2], v0[3]); w.z = cvt_pk_bf16(v1[0], v1[1]); w.w = cvt_pk_bf16(v1[2], v1[3]);
    *(u32x4*)p = w;
}
struct EpiInProj {
    bf16_t* PP; const float* qgain; const float* kgain; const float* bmerge; const f32x2* tab;
    __device__ __forceinline__ void operator()(AccT& acc, const pg8::Unit& u, int wr, int wc, int fr, int fq, LAS unsigned char* scr, int wid, int lane) const {
        const int seg = u.pn >> 2, ct = u.pn & 3;
        bf16_t* O = PP + (size_t)seg * PTOK * 1024;
        const int rt0 = wr * 64 + fr;
        const int cw = wc * 32 + 8 * fq;
        LAS float* P = (LAS float*)scr;
        f32x4 c0[2], c1[2];
        c0[0] = c0[1] = c1[0] = c1[1] = (f32x4){0.f, 0.f, 0.f, 0.f};
        if (seg <= 1) {
#pragma unroll
            for (int ai = 0; ai < 2; ++ai)
#pragma unroll
                for (int m = 0; m < 4; ++m)
#pragma unroll
                    for (int bj = 0; bj < 2; ++bj) {
                        const f32x4 a = acc[ai][bj][m][0], b = acc[ai][bj][m][1];
                        float s = (a[0] * a[0] + a[1] * a[1]) + (a[2] * a[2] + a[3] * a[3]) + (b[0] * b[0] + b[1] * b[1]) + (b[2] * b[2] + b[3] * b[3]);
                        s += __shfl_xor(s, 16); s += __shfl_xor(s, 32);
                        if (fq == 0) P[(ai * 128 + rt0 + m * 16) * 8 + bj * 4 + wc] = s;
                    }
            LDS_WAIT(); __builtin_amdgcn_s_barrier(); asm volatile("" ::: "memory");
            const float* gp = (seg == 0 ? qgain : kgain) + cw;
            c0[0] = c0[1] = *(const f32x4*)gp; c1[0] = c1[1] = *(const f32x4*)(gp + 4);
        } else if (seg >= 8) {
            const float* bp = bmerge + (seg - 8) * 1024 + ct * 256 + cw;
            c0[0] = *(const f32x4*)bp; c1[0] = *(const f32x4*)(bp + 4); c0[1] = *(const f32x4*)(bp + 128); c1[1] = *(const f32x4*)(bp + 132);
        }
#pragma unroll
        for (int ai = 0; ai < 2; ++ai)
#pragma unroll
            for (int m = 0; m < 4; ++m) {
                const int rt = ai * 128 + rt0 + m * 16;
                f32x4 v[2][2];
#pragma unroll
                for (int bj = 0; bj < 2; ++bj) { v[bj][0] = acc[ai][bj][m][0]; v[bj][1] = acc[ai][bj][m][1]; }
                if (seg <= 1) {
                    const float sc = (seg == 0) ? QSCALE : 1.0f;
#pragma unroll
                    for (int bj = 0; bj < 2; ++bj) {
                        const f32x4 p = *(const LAS f32x4*)(P + rt * 8 + bj * 4);
                        const float rs = sc / sqrtf(((p[0] + p[1]) + (p[2] + p[3])) * (1.0f / 128.0f) + EPS);
                        v[bj][0] = v[bj][0] * c0[bj] * rs; v[bj][1] = v[bj][1] * c1[bj] * rs;
                    }
                } else if (seg == 3 || seg == 7) {
#pragma unroll
                    for (int bj = 0; bj < 2; ++bj)
#pragma unroll
                        for (int j = 0; j < 4; ++j) { v[bj][0][j] = v[bj][0][j] * fast_sigmoid(v[bj][0][j]); v[bj][1][j] = v[bj][1][j] * fast_sigmoid(v[bj][1][j]); }
                } else if (seg >= 8) {
#pragma unroll
                    for (int bj = 0; bj < 2; ++bj)
#pragma unroll
                        for (int j = 0; j < 4; ++j) { v[bj][0][j] = fast_sigmoid(v[bj][0][j] + c0[bj][j]); v[bj][1][j] = fast_sigmoid(v[bj][1][j] + c1[bj][j]); }
                } else if (seg == 4 || seg == 5) {
                    const float sc = (seg == 5) ? 0.0625f : 1.0f;
                    const int pos = (u.pm * 256 + rt) & (SEQ - 1);
                    const f32x4* tp = (const f32x4*)(tab + (size_t)pos * 128 + cw);
#pragma unroll
                    for (int n = 0; n < 2; ++n) {
                        const f32x4 t0 = tp[2 * n], t1 = tp[2 * n + 1];
                        const float cs[4] = {t0[0], t0[2], t1[0], t1[2]}, sn[4] = {t0[1], t0[3], t1[1], t1[3]};
#pragma unroll
                        for (int j = 0; j < 4; ++j) {
                            const float x1 = v[0][n][j], x2 = v[1][n][j];
                            v[0][n][j] = (x1 * cs[j] - x2 * sn[j]) * sc; v[1][n][j] = (x1 * sn[j] + x2 * cs[j]) * sc;
                        }
                    }
                }
                bf16_t* rowp = O + (size_t)(u.pm * 256 + rt) * 1024 + ct * 256 + cw;
                st8(rowp, v[0][0], v[0][1]); st8(rowp + 128, v[1][0], v[1][1]);
                if (m & 1) asm volatile("" ::: "memory");
            }
    }
};
template <bool ADD> struct EpiGate {
    const bf16_t* gate; const bf16_t* prev; bf16_t* out;
    __device__ __forceinline__ void operator()(AccT& acc, const pg8::Unit& u, int wr, int wc, int fr, int fq, LAS unsigned char* scr, int wid, int lane) const {
#pragma unroll
        for (int ai = 0; ai < 2; ++ai)
#pragma unroll
            for (int m = 0; m < 4; ++m) {
                const size_t off = (size_t)(u.pm * 256 + ai * 128 + wr * 64 + m * 16 + fr) * 1024 + u.pn * 256 + wc * 32 + 8 * fq;
#pragma unroll
                for (int bj = 0; bj < 2; ++bj) {
                    const u32x4 g = *(const u32x4*)(gate + off + bj * 128);
                    f32x4 v0 = acc[ai][bj][m][0], v1 = acc[ai][bj][m][1];
                    v0[0] *= bf_lo(g.x); v0[1] *= bf_hi(g.x); v0[2] *= bf_lo(g.y); v0[3] *= bf_hi(g.y);
                    v1[0] *= bf_lo(g.z); v1[1] *= bf_hi(g.z); v1[2] *= bf_lo(g.w); v1[3] *= bf_hi(g.w);
                    if (ADD) { const u32x4 p = *(const u32x4*)(prev + off + bj * 128);
                        v0[0] += bf_lo(p.x); v0[1] += bf_hi(p.x); v0[2] += bf_lo(p.y); v0[3] += bf_hi(p.y);
                        v1[0] += bf_lo(p.z); v1[1] += bf_hi(p.z); v1[2] += bf_lo(p.w); v1[3] += bf_hi(p.w); }
                    st8(out + off + bj * 128, v0, v1);
                }
            }
    }
};
struct EpiOut {
    const float* x; float* out;
    __device__ __forceinline__ void operator()(AccT& acc, const pg8::Unit& u, int wr, int wc, int fr, int fq, LAS unsigned char* scr, int wid, int lane) const {
#pragma unroll
        for (int ai = 0; ai < 2; ++ai)
#pragma unroll
            for (int m = 0; m < 4; ++m) {
                const size_t off = (size_t)(u.pm * 256 + ai * 128 + wr * 64 + m * 16 + fr) * 1024 + u.pn * 256 + wc * 32 + 8 * fq;
#pragma unroll
                for (int bj = 0; bj < 2; ++bj)
#pragma unroll
                    for (int n = 0; n < 2; ++n) { const f32x4 xv = *(const f32x4*)(x + off + bj * 128 + 4 * n); *(f32x4*)(out + off + bj * 128 + 4 * n) = xv + acc[ai][bj][m][n]; }
            }
    }
};

#define XB_TMO      128
#define XB_XCNT(j)  (256  + 64 * (j))
#define XB_XSUB(j)  (1280 + 64 * (j))
#define XB_XGEN(j)  (2304 + 64 * (j))
#define XB_TOP      3328
#define XB_TOPGEN   3392
#define XCD_BAR_WORDS 3456
#define XB_SPIN_CAP (1u << 18)
__device__ __forceinline__ unsigned xb_ld(unsigned* p)              { return __hip_atomic_load(p, __ATOMIC_RELAXED, __HIP_MEMORY_SCOPE_AGENT); }
__device__ __forceinline__ unsigned xb_add(unsigned* p, unsigned v) { return __hip_atomic_fetch_add(p, v, __ATOMIC_RELAXED, __HIP_MEMORY_SCOPE_AGENT); }
__device__ __forceinline__ unsigned xb_xcc_id() { return (unsigned)__builtin_amdgcn_s_getreg((3 << 11) | 20) & 0xFu; }
#define XB_SPIN(cond, bar) do { unsigned _sp = 0; while (cond) { __builtin_amdgcn_s_sleep(1); \
    if ((++_sp & 255u) == 0u) { if (xb_ld(&(bar)[XB_TMO])) break; if (_sp > XB_SPIN_CAP) { atomicAdd(&(bar)[XB_TMO], 1u); break; } } } } while (0)
struct XcdBarrier { unsigned* bar; unsigned x; volatile LAS unsigned* st; };
__device__ __forceinline__ XcdBarrier xcd_barrier_post(unsigned* bar, volatile LAS unsigned* st) {
    XcdBarrier b; b.bar = bar; b.x = xb_xcc_id(); b.st = st;
    if (threadIdx.x == 0) (void)xb_add(&bar[XB_XCNT(b.x)], 1u);
    return b;
}
__device__ __forceinline__ void xcd_barrier_complete(unsigned* bar, unsigned x, unsigned& nloc, unsigned& nx) {
    const unsigned G = gridDim.x * gridDim.y * gridDim.z;
    unsigned sum, cnt, mine, sp = 0u;
    for (;;) {
        sum = 0u; cnt = 0u; mine = 0u;
#pragma unroll
        for (unsigned j = 0; j < 16; ++j) { const unsigned c = xb_ld(&bar[XB_XCNT(j)]); sum += c; cnt += (c > 0u) ? 1u : 0u; mine = (j == x) ? c : mine; }
        if (sum == G) break;
        __builtin_amdgcn_s_sleep(1);
        if ((++sp & 255u) == 0u) { if (xb_ld(&bar[XB_TMO])) break; if (sp > XB_SPIN_CAP) { atomicAdd(&bar[XB_TMO], 1u); break; } }
    }
    nloc = mine > 0u ? mine : 1u; nx = cnt > 0u ? cnt : 1u;
}
__device__ __forceinline__ void xcd_barrier(const XcdBarrier& b) {
    asm volatile("s_waitcnt vmcnt(0)" ::: "memory");
    __syncthreads();
    if (threadIdx.x == 0) {
        unsigned* bar = b.bar;
        __builtin_amdgcn_s_waitcnt(0);
        unsigned nloc = b.st[0], nx = b.st[1];
        if (nloc == 0u) { xcd_barrier_complete(bar, b.x, nloc, nx); b.st[0] = nloc; b.st[1] = nx; }
        const unsigned old = xb_add(&bar[XB_XSUB(b.x)], 1u);
        const unsigned gen = old / nloc;
        if (old + 1u == (gen + 1u) * nloc) {
            __builtin_amdgcn_fence(__ATOMIC_RELEASE, "agent");
            asm volatile("s_waitcnt vmcnt(0)" ::: "memory");
            const unsigned og = xb_add(&bar[XB_TOP], 1u);
            const unsigned tg = og / nx;
            if (og + 1u == (tg + 1u) * nx) xb_add(&bar[XB_TOPGEN], 1u);
            else XB_SPIN(xb_ld(&bar[XB_TOPGEN]) == tg, bar);
            __builtin_amdgcn_fence(__ATOMIC_ACQUIRE, "agent");
            xb_add(&bar[XB_XGEN(b.x)], 1u);
            asm volatile("s_waitcnt vmcnt(0)" ::: "memory");
        } else {
            XB_SPIN(xb_ld(&bar[XB_XGEN(b.x)]) == gen, bar);
            __builtin_amdgcn_fence(__ATOMIC_ACQUIRE, "agent");
            asm volatile("s_waitcnt vmcnt(0)" ::: "memory");
        }
    }
    __syncthreads();
}

__device__ __forceinline__ void p0_transpose_item(const float* W, int K, int N, bf16_t* WT, LAS float* scr, int item, int lane) {
    const int nblk = N / 32, kb = item / nblk, nb = item % nblk, k0 = 64 * kb, n0 = 32 * nb;
#pragma unroll 8
    for (int i = 0; i < 32; ++i) { const int kk = 2 * i + (lane >> 5); scr[kk * 33 + (lane & 31)] = W[(size_t)(k0 + kk) * N + n0 + (lane & 31)]; }
    LDS_WAIT(); asm volatile("" ::: "memory");
    const int c = lane & 7;
#pragma unroll
    for (int j = 0; j < 4; ++j) { const int n = (lane >> 3) + 8 * j; const LAS float* s = scr + (8 * c) * 33 + n;
        u32x4 o; o.x = cvt_pk_bf16(s[0 * 33], s[1 * 33]); o.y = cvt_pk_bf16(s[2 * 33], s[3 * 33]); o.z = cvt_pk_bf16(s[4 * 33], s[5 * 33]); o.w = cvt_pk_bf16(s[6 * 33], s[7 * 33]);
        *(u32x4*)(WT + (size_t)(n0 + n) * K + k0 + 8 * c) = o; }
    LDS_WAIT(); asm volatile("" ::: "memory");
}
__device__ __forceinline__ void p0_prologue(LAS unsigned char* lds, int vcu, int G, int wave, int lane, const float* x, const float* ngain, const float* w_in, const float* w_sb, const float* w_ret, const float* w_out,
                                            bf16_t* WinT, bf16_t* WsbT, bf16_t* WretT, bf16_t* WoutT, bf16_t* H, f32x2* tab) {
    asm volatile("" : "+v"(lane));
    LAS float* scr = (LAS float*)(lds + wave * 16384);
    const int gw = vcu * NWAVES + wave, NGW = G * NWAVES;
    constexpr int I_IN = (D / 64) * (INC / 32), I_SQ = (D / 64) * (D / 32);
    for (int it = gw; it < I_IN + 3 * I_SQ; it += NGW) {
        int r = it;
        if (r < I_IN) { p0_transpose_item(w_in, D, INC, WinT, scr, r, lane); continue; } r -= I_IN;
        if (r < I_SQ) { p0_transpose_item(w_sb, D, D, WsbT, scr, r, lane); continue; } r -= I_SQ;
        if (r < I_SQ) { p0_transpose_item(w_ret, D, D, WretT, scr, r, lane); continue; } r -= I_SQ;
        p0_transpose_item(w_out, D, D, WoutT, scr, r, lane);
    }
    f32x4 g[4];
#pragma unroll
    for (int j = 0; j < 4; ++j) g[j] = ((const f32x4*)ngain)[64 * j + lane];
    for (int m = gw; m < NTOK; m += NGW) {
        const f32x4* xr = (const f32x4*)(x + (size_t)m * D) + lane;
        f32x4 v[4]; float s = 0.f;
#pragma unroll
        for (int j = 0; j < 4; ++j) { v[j] = xr[64 * j]; s += (v[j][0] * v[j][0] + v[j][1] * v[j][1]) + (v[j][2] * v[j][2] + v[j][3] * v[j][3]); }
        const float rs = 1.0f / sqrtf(wave_sum(s) * (1.0f / D) + EPS);
        u32x2* o = (u32x2*)(H + (size_t)m * D) + lane;
#pragma unroll
        for (int j = 0; j < 4; ++j) { const f32x4 y = v[j] * rs * g[j]; u32x2 w; w.x = cvt_pk_bf16(y[0], y[1]); w.y = cvt_pk_bf16(y[2], y[3]); o[64 * j] = w; }
    }
    for (int e = (vcu * NWAVES + wave) * 64 + lane; e < SEQ * 128; e += G * NWAVES * 64) {
        const int pos = e >> 7, i = e & 127;
        const float angf = (float)pos * INVF[i];
        const double a = (double)angf;
        const double k = __builtin_rint(a * 0.63661977236758134308);
        double r = __builtin_fma(-k, 1.57079632679489655800, a); r = __builtin_fma(-k, 6.12323399573676603587e-17, r);
        const double r2 = r * r;
        double sp = 1.0 / 6227020800.0; sp = sp * r2 - 1.0 / 39916800.0; sp = sp * r2 + 1.0 / 362880.0; sp = sp * r2 - 1.0 / 5040.0; sp = sp * r2 + 1.0 / 120.0; sp = sp * r2 - 1.0 / 6.0; sp = sp * r2 + 1.0;
        const double sn = r * sp;
        double cp = -1.0 / 87178291200.0; cp = cp * r2 + 1.0 / 479001600.0; cp = cp * r2 - 1.0 / 3628800.0; cp = cp * r2 + 1.0 / 40320.0; cp = cp * r2 - 1.0 / 720.0; cp = cp * r2 + 1.0 / 24.0; cp = cp * r2 - 0.5; cp = cp * r2 + 1.0;
        const int q = (int)((long long)k & 3);
        const double c_ = (q == 0) ? cp : (q == 1) ? -sn : (q == 2) ? -cp : sn;
        const double s_ = (q == 0) ? sn : (q == 1) ? cp : (q == 2) ? -sn : -cp;
        tab[e] = (f32x2){(float)c_, (float)s_};
    }
}

__device__ __forceinline__ void naive_attention(int gw, int NGW, int lane, bf16_t* QS, const bf16_t* KS, const bf16_t* VS, const bf16_t* GS) {
    asm volatile("" : "+v"(lane));
    for (int task = gw; task < 2 * SBH * SEQ; task += NGW) {
        const int t = task & (SEQ - 1), bh = task >> 13, h = bh & 7, bl = bh >> 3;
        const size_t rowq = (size_t)(bl * SEQ + t) * 1024 + h * SBD + 2 * lane;
        const unsigned qw = *(const unsigned*)(QS + rowq);
        const float q0 = bf_lo(qw), q1 = bf_hi(qw);
        float a0 = 0.f, a1 = 0.f, run = 0.f;
        const bf16_t* kb = KS + (size_t)(bl * SEQ) * 1024 + h * SBD + 2 * lane;
        const bf16_t* vb = VS + (size_t)(bl * SEQ) * 1024 + h * SBD + 2 * lane;
        for (int s = t - 1; s >= 0; --s) {
            const unsigned kw = *(const unsigned*)(kb + (size_t)s * 1024);
            const unsigned vw = *(const unsigned*)(vb + (size_t)s * 1024);
            const float y = wave_sum(q0 * bf_lo(kw) + q1 * bf_hi(kw));
            const float z = y * LN2F;
            const float sp = fmaxf(z, 0.f) + log1pf(expf(-fabsf(z)));
            const float w = expf((z - sp) + run);
            run -= sp;
            a0 += w * bf_lo(vw); a1 += w * bf_hi(vw);
            if (run < -110.f) break;
        }
        const unsigned gwd = *(const unsigned*)(GS + rowq);
        *(unsigned*)(QS + rowq) = cvt_pk_bf16(a0 * bf_lo(gwd), a1 * bf_hi(gwd));
    }
}
__device__ __forceinline__ void naive_retention(int gw, int NGW, int lane, bf16_t* RQ, const bf16_t* RK, const bf16_t* RV, const bf16_t* GR, const float* rgain) {
    asm volatile("" : "+v"(lane));
    for (int task = gw; task < 2 * RH * SEQ; task += NGW) {
        const int t = task & (SEQ - 1), bh = task >> 13, h = bh & 3, bl = bh >> 2;
        const size_t rowq = (size_t)(bl * SEQ + t) * 1024 + h * RD + 4 * lane;
        const u32x2 qw = *(const u32x2*)(RQ + rowq);
        const float q0 = bf_lo(qw.x), q1 = bf_hi(qw.x), q2 = bf_lo(qw.y), q3 = bf_hi(qw.y);
        float a0 = 0.f, a1 = 0.f, a2 = 0.f, a3 = 0.f;
        const bf16_t* kb = RK + (size_t)(bl * SEQ) * 1024 + h * RD + 4 * lane;
        const bf16_t* vb = RV + (size_t)(bl * SEQ) * 1024 + h * RD + 4 * lane;
        const float l2g = log2gamma(h);
        const int send = (t | 63) + 1;
#pragma unroll 4
        for (int s = 0; s < send; ++s) {
            const u32x2 kw = *(const u32x2*)(kb + (size_t)s * 1024);
            const u32x2 vw = *(const u32x2*)(vb + (size_t)s * 1024);
            const float d = wave_sum((q0 * bf_lo(kw.x) + q1 * bf_hi(kw.x)) + (q2 * bf_lo(kw.y) + q3 * bf_hi(kw.y)));
            const int dist = t > s ? t - s : s - t;
            const float w = d * __builtin_amdgcn_exp2f(l2g * (float)dist);
            a0 += w * bf_lo(vw.x); a1 += w * bf_hi(vw.x); a2 += w * bf_lo(vw.y); a3 += w * bf_hi(vw.y);
        }
        const float ss = wave_sum((a0 * a0 + a1 * a1) + (a2 * a2 + a3 * a3));
        const float rs = 1.0f / sqrtf(ss * (1.0f / RD) + EPS);
        const f32x4 g = *(const f32x4*)(rgain + h * RD + 4 * lane);
        const u32x2 gw2 = *(const u32x2*)(GR + rowq);
        u32x2 o; o.x = cvt_pk_bf16(a0 * rs * g[0] * bf_lo(gw2.x), a1 * rs * g[1] * bf_hi(gw2.x)); o.y = cvt_pk_bf16(a2 * rs * g[2] * bf_lo(gw2.y), a3 * rs * g[3] * bf_hi(gw2.y));
        *(u32x2*)(RQ + rowq) = o;
    }
}

constexpr int NPHASE = 1 + 5 * NPASS;
struct Args { const float* in[10]; float* out; unsigned char* ws; int ph_lo, ph_hi; };
__device__ __forceinline__ unsigned char* lds_ptr(volatile LAS unsigned* tabl, int i) {
    const unsigned lo = __builtin_amdgcn_readfirstlane(tabl[2 * i]), hi = __builtin_amdgcn_readfirstlane(tabl[2 * i + 1]);
    return (unsigned char*)(((unsigned long long)hi << 32) | lo);
}
__global__ void __launch_bounds__(NWAVES * 64, 2) fwd(Args args) {
    extern __shared__ __attribute__((aligned(16))) unsigned char lds_raw[];
    LAS unsigned char* lds = (LAS unsigned char*)lds_raw;
    volatile LAS unsigned* MISC = (volatile LAS unsigned*)(lds + MISC_OFF);
    const int tid = threadIdx.x, lane = tid & 63, wave = __builtin_amdgcn_readfirstlane(tid >> 6);
    if (tid < 32) MISC[tid] = 0u;
    if (tid < 12) { const unsigned long long pv = (tid < 10) ? (unsigned long long)args.in[tid] : (tid == 10) ? (unsigned long long)args.out : (unsigned long long)args.ws;
        MISC[32 + 2 * tid] = (unsigned)pv; MISC[32 + 2 * tid + 1] = (unsigned)(pv >> 32); }
    __syncthreads();
    volatile LAS unsigned* PT = MISC + 32;
#define P_IN(i) ((const float*)lds_ptr(PT, (i)))
#define P_OUT() ((float*)lds_ptr(PT, 10))
#define P_WS() (lds_ptr(PT, 11))
    const int lo = args.ph_lo, hi = args.ph_hi;
    const bool use_bar = (hi - lo) > 1;
    XcdBarrier bar; bar.bar = (unsigned*)(args.ws + WS_CTL) + CW_BAR; bar.x = 0; bar.st = MISC + 8;
    if (use_bar) bar = xcd_barrier_post((unsigned*)(args.ws + WS_CTL) + CW_BAR, MISC + 8);
#define IN(k) (lo <= (k) && (k) < hi)
#define BOTH(k) (IN(k) && IN((k) + 1))
#define GRID_BAR() xcd_barrier(bar)
#define VCU() ((int)((gridDim.x % 8 == 0) ? (blockIdx.x % 8) * (gridDim.x / 8) + blockIdx.x / 8 : blockIdx.x))
    LAS unsigned char* scr = lds + SCR_OFF;

    if (IN(0)) {
        unsigned char* ws = P_WS();
        p0_prologue(lds, VCU(), gridDim.x, wave, lane, P_IN(0), P_IN(1), P_IN(2), P_IN(7), P_IN(8), P_IN(9),
                    (bf16_t*)(ws + WS_WIN), (bf16_t*)(ws + WS_WSB), (bf16_t*)(ws + WS_WRET), (bf16_t*)(ws + WS_WOUT), (bf16_t*)(ws + WS_H), (f32x2*)(ws + WS_TAB));
        if (BOTH(0)) GRID_BAR();
    }

    _Pragma("unroll") for (int p = 0; p < NPASS; ++p) {
        const int pb = 1 + 5 * p;
        if (IN(pb + 0)) {
            unsigned char* ws = P_WS();
            pg8::StaticOrder S; S.init(PTOK, INC, gridDim.x, blockIdx.x, ws + WS_H + (size_t)p * ARR, ws + WS_WIN, D, D);
            EpiInProj E{(bf16_t*)(ws + WS_PP), P_IN(4), P_IN(5), P_IN(3), (const f32x2*)(ws + WS_TAB)};
            pg8::gemm_phase(lds, scr, D, D, D, S, E);
            if (BOTH(pb + 0)) GRID_BAR();
        }
        if (IN(pb + 1)) {
            unsigned char* ws = P_WS();
            const int gw = VCU() * NWAVES + wave, NGW = gridDim.x * NWAVES;
            bf16_t* PPb = (bf16_t*)(ws + WS_PP);
            naive_attention(gw, NGW, lane, PPb + A_QS * (size_t)PTOK * 1024, PPb + A_KS * (size_t)PTOK * 1024, PPb + A_VS * (size_t)PTOK * 1024, PPb + A_GS * (size_t)PTOK * 1024);
            naive_retention(gw, NGW, lane, PPb + A_RQ * (size_t)PTOK * 1024, PPb + A_RK * (size_t)PTOK * 1024, PPb + A_RV * (size_t)PTOK * 1024, PPb + A_GR * (size_t)PTOK * 1024, P_IN(6));
            if (BOTH(pb + 1)) GRID_BAR();
        }
        if (IN(pb + 2)) {
            unsigned char* ws = P_WS();
            pg8::StaticOrder S; S.init(PTOK, D, gridDim.x, blockIdx.x, ws + WS_PP + A_QS * ARR, ws + WS_WSB, D, D);
            EpiGate<false> E{(const bf16_t*)(ws + WS_PP + A_MA * ARR), nullptr, (bf16_t*)(ws + WS_T1)};
            pg8::gemm_phase(lds, scr, D, D, D, S, E);
            if (BOTH(pb + 2)) GRID_BAR();
        }
        if (IN(pb + 3)) {
            unsigned char* ws = P_WS();
            pg8::StaticOrder S; S.init(PTOK, D, gridDim.x, blockIdx.x, ws + WS_PP + A_RQ * ARR, ws + WS_WRET, D, D);
            EpiGate<true> E{(const bf16_t*)(ws + WS_PP + A_MB * ARR), (const bf16_t*)(ws + WS_T1), (bf16_t*)(ws + WS_MG)};
            pg8::gemm_phase(lds, scr, D, D, D, S, E);
            if (BOTH(pb + 3)) GRID_BAR();
        }
        if (IN(pb + 4)) {
            unsigned char* ws = P_WS();
            pg8::StaticOrder S; S.init(PTOK, D, gridDim.x, blockIdx.x, ws + WS_MG, ws + WS_WOUT, D, D);
            EpiOut E{P_IN(0) + (size_t)p * PTOK * D, P_OUT() + (size_t)p * PTOK * D};
            pg8::gemm_phase(lds, scr, D, D, D, S, E);
            if (BOTH(pb + 4)) GRID_BAR();
        }
    }
#undef IN
#undef BOTH
#undef GRID_BAR
}

extern "C" void kernel_launch(void* const* d_in, const int* in_sizes, int n_in, void* d_out, int out_size, void* d_ws, size_t ws_size, hipStream_t stream) {
    static int grid = 0;
    if (grid == 0) {
        if (n_in != 10 || in_sizes[0] != NTOK * D || out_size != NTOK * D || ws_size < WS_END) { fprintf(stderr, "kernel_launch: unexpected shapes / workspace (%zu < %zu)\n", ws_size, (size_t)WS_END); grid = -1; return; }
        int dev = 0, cus = 0;
        if (hipGetDevice(&dev) != hipSuccess || hipDeviceGetAttribute(&cus, hipDeviceAttributeMultiprocessorCount, dev) != hipSuccess) { grid = -1; return; }
        if (hipFuncSetAttribute((const void*)fwd, hipFuncAttributeMaxDynamicSharedMemorySize, LDS_BYTES) != hipSuccess) { fprintf(stderr, "kernel_launch: hipFuncSetAttribute failed\n"); grid = -1; return; }
        (void)hipGetLastError();
        grid = cus;
    }
    if (grid < 0) return;
    (void)hipMemsetAsync((char*)d_ws + WS_CTL, 0, CTL_ZERO_BYTES, stream);
    Args a{};
    for (int i = 0; i < 10; ++i) a.in[i] = (const float*)d_in[i];
    a.out = (float*)d_out; a.ws = (unsigned char*)d_ws;
    a.ph_lo = 0; a.ph_hi = NPHASE;
    hipLaunchKernelGGL(fwd, dim3(grid), dim3(NWAVES * 64), LDS_BYTES, stream, a);
}
```

```cpp
#include <hip/hip_runtime.h>
#include <cstdio>
#include <cstdint>

#define LAS __attribute__((address_space(3)))
#define GAS __attribute__((address_space(1)))
typedef unsigned short bf16_t;
typedef short bf16x8 __attribute__((ext_vector_type(8)));
typedef float f32x4 __attribute__((ext_vector_type(4)));
typedef float f32x2 __attribute__((ext_vector_type(2)));
typedef unsigned u32x4 __attribute__((ext_vector_type(4)));
typedef unsigned u32x2 __attribute__((ext_vector_type(2)));

constexpr int D = 1024, BATCH = 4, SEQ = 8192, NTOK = BATCH * SEQ;
constexpr int NPASS = 2, PTOK = NTOK / NPASS;
constexpr int INC = 10240;
constexpr int SBH = 8, SBD = 128, RH = 4, RD = 256;
constexpr float EPS = 1e-6f;
constexpr float QSCALE = 0.12751743082459868f;
constexpr float LN2F = 0.6931471805599453f;
constexpr size_t MiB = 1u << 20;
constexpr size_t WS_CTL = 0, CTL_ZERO_BYTES = 1 * MiB;
constexpr size_t WS_WIN = 1 * MiB, WS_WSB = 21 * MiB, WS_WRET = 23 * MiB, WS_WOUT = 25 * MiB, WS_TAB = 27 * MiB, WS_H = 35 * MiB;
constexpr size_t WS_PP = 99 * MiB;
constexpr size_t ARR = (size_t)PTOK * 1024 * 2;
constexpr size_t WS_T1 = WS_PP + 10 * ARR, WS_MG = WS_T1 + ARR, WS_END = WS_MG + ARR;
enum { A_QS = 0, A_KS, A_VS, A_GS, A_RQ, A_RK, A_RV, A_GR, A_MA, A_MB };
constexpr int CW_BAR = 4096;
constexpr int RING_BYTES = 131072, SCR_OFF = RING_BYTES, SCR_BYTES = 8192, MISC_OFF = SCR_OFF + SCR_BYTES, LDS_BYTES = 147456;
constexpr int NWAVES = 8;

__device__ const float INVF[128] = {
1.0f, 0.930572033f, 0.865964353f, 0.805842161f, 0.749894261f, 0.697830617f, 0.649381638f, 0.604296386f, 0.562341332f, 0.523299098f, 0.486967534f, 0.453158379f, 0.421696514f, 0.392418981f, 0.365174115f, 0.339820832f, 0.316227764f, 0.294272691f, 0.273841977f, 0.254829675f, 0.237137377f, 0.220673412f, 0.2053525f, 0.191095307f, 0.177827939f, 0.165481716f, 0.153992653f, 0.143301249f, 0.133352131f, 0.124093778f, 0.115478203f, 0.107460782f, 0.100000001f, 0.0930572078f, 0.0865964293f, 0.0805842131f, 0.0749894157f, 0.0697830617f, 0.0649381652f, 0.0604296401f, 0.0562341325f, 0.0523299128f, 0.0486967526f, 0.0453158356f, 0.0421696529f, 0.0392418951f, 0.0365174115f, 0.0339820832f, 0.0316227749f, 0.0294272713f, 0.0273841973f, 0.0254829675f, 0.0237137377f, 0.0220673401f, 0.0205352511f, 0.0191095285f, 0.0177827943f, 0.0165481698f, 0.0153992651f, 0.0143301254f, 0.0133352149f, 0.0124093778f, 0.0115478206f, 0.0107460786f, 0.00999999978f, 0.00930572022f, 0.00865964312f, 0.00805842225f, 0.00749894185f, 0.00697830599f, 0.00649381615f, 0.00604296383f, 0.00562341325f, 0.00523299119f, 0.00486967526f, 0.00453158328f, 0.00421696482f, 0.0039241896f, 0.00365174119f, 0.00339820841f, 0.00316227763f, 0.00294272718f, 0.00273841969f, 0.00254829694f, 0.00237137359f, 0.00220673415f, 0.00205352483f, 0.00191095297f, 0.00177827943f, 0.00165481714f, 0.00153992651f, 0.00143301254f, 0.00133352145f, 0.00124093774f, 0.0011547819f, 0.00107460783f, 0.00100000005f, 0.000930572045f, 0.000865964335f, 0.000805842166f, 0.000749894243f, 0.000697830576f, 0.000649381662f, 0.000604296394f, 0.000562341302f, 0.000523299095f, 0.000486967532f, 0.000453158369f, 0.000421696517f, 0.000392418966f, 0.000365174143f, 0.000339820836f, 0.000316227757f, 0.000294272701f, 0.000273841957f, 0.000254829676f, 0.00023713737f, 0.000220673406f, 0.00020535251f, 0.0001910953f, 0.00017782794f, 0.000165481717f, 0.000153992645f, 0.000143301251f, 0.00013335215f, 0.000124093771f, 0.0001154782f, 0.000107460786f };
__device__ __forceinline__ float log2gamma(int h) { return h == 0 ? -0.04580368961312479f : h == 1 ? -0.02272007650008353f : h == 2 ? -0.011315313227834146f : -0.005646563141142063f; }

__device__ __forceinline__ unsigned cvt_pk_bf16(float lo, float hi) { unsigned r; asm volatile("v_cvt_pk_bf16_f32 %0, %1, %2" : "=v"(r) : "v"(lo), "v"(hi)); return r; }
__device__ __forceinline__ float bf_lo(unsigned w) { return __uint_as_float(w << 16); }
__device__ __forceinline__ float bf_hi(unsigned w) { return __uint_as_float(w & 0xffff0000u); }
__device__ __forceinline__ float wave_sum(float v) {
#pragma unroll
    for (int o = 1; o < 64; o <<= 1) v += __shfl_xor(v, o);
    return v;
}
__device__ __forceinline__ float fast_sigmoid(float v) { return __builtin_amdgcn_rcpf(1.0f + __builtin_amdgcn_exp2f(-1.4426950408889634f * v)); }
#define LDS_WAIT() asm volatile("s_waitcnt lgkmcnt(0)" ::: "memory")
#define VM_WAIT() asm volatile("s_waitcnt vmcnt(0)" ::: "memory")

namespace pg8 {
constexpr int BM = 256, BK = 64, HALF = 128, HTB = HALF * BK * 2, STAGE_BYTES = 8 * HTB;
__host__ __device__ __forceinline__ int lds_byte(int r, int c) { const int st = (r >> 4) * 2 + (c >> 5), rr = r & 15, cc = c & 31, ob = rr * 64 + cc * 2; return st * 1024 + (ob ^ (((ob >> 9) & 1) << 5)); }
__host__ __device__ __forceinline__ void stage_rc(int b, int& R, int& C) { const int st = b / 1024, sb = b % 1024, swz = sb ^ (((sb >> 9) & 1) << 5); R = (st >> 1) * 16 + swz / 64; C = (st & 1) * 32 + (swz % 64) / 2; }
__host__ __device__ __forceinline__ int perm32(int rho) { const int n = rho >> 4, i = rho & 15; return 8 * (i >> 2) + 4 * n + (i & 3); }
struct Unit { int pm, pn; };

struct StaticOrder {
    int nM, nN, nwg, G, c; const char* A; const char* B; size_t tA, tB;
    __device__ void init(int M, int N, int G_, int c_, const void* A_, const void* B_, int lda, int ldb) { nM = M / BM; nN = N / BM; nwg = nM * nN; G = G_; c = c_; A = (const char*)A_; B = (const char*)B_; tA = (size_t)BM * lda * 2; tB = (size_t)BM * ldb * 2; }
    __device__ bool next(int i, Unit& u) const {
        const long L = (long)i * G + c; if (L >= nwg) return false;
        int wgid = (int)L; { const int q = nwg / 8, r = nwg % 8, xcd = wgid % 8, off = wgid / 8; wgid = (xcd < r ? xcd * (q + 1) : r * (q + 1) + (xcd - r) * q) + off; }
        const int nig = 8 * nN, gid = wgid / nig, fm = gid * 8, gsz = (nM - fm) < 8 ? (nM - fm) : 8;
        u.pm = fm + ((wgid % nig) % gsz); u.pn = (wgid % nig) / gsz; return true;
    }
    __device__ __forceinline__ void ptrs(const Unit& u, const char*& a, const char*& b) const { a = A + (size_t)u.pm * tA; b = B + (size_t)u.pn * tB; }
};

template <class Epi, class Sched>
__device__ __forceinline__ void gemm_phase(LAS unsigned char* lds, LAS unsigned char* scr, const int K, const int lda, const int ldb, const Sched& S, const Epi& E) {
    int tid = threadIdx.x; asm volatile("" : "+v"(tid));
    const int wid = __builtin_amdgcn_readfirstlane(tid >> 6), lane = tid & 63, wr = wid >> 2, wc = wid & 3, fr = lane & 15, fq = lane >> 4;
    const int nt = K / BK;
    unsigned voffA[2], voffB[2];
#pragma unroll
    for (int i = 0; i < 2; ++i) { int R, C; stage_rc(tid * 16 + i * 8192, R, C); const int Rb = (R & ~31) + perm32(R & 31);
        voffA[i] = (unsigned)(R * lda + C) * 2u; voffB[i] = (unsigned)(Rb * ldb + C) * 2u; }
    const size_t kstep = (size_t)(BK * 2);
    const size_t hstepA = (size_t)HALF * lda * 2, hstepB = (size_t)HALF * ldb * 2;
    const unsigned ldsw = (unsigned)wid * 1024u;
    const int aoff = lds_byte(wr * 64 + fr, fq * 8), boff = lds_byte(wc * 32 + fr, fq * 8);
#define PG8_SA(b, h) (((b) * 2 + (h)) * HTB)
#define PG8_SB(b, h) ((4 + (b) * 2 + (h)) * HTB)
#define PG8_STAGE(bufoff, gbase, voff) do { _Pragma("unroll") for (int _i = 0; _i < 2; ++_i) \
        __builtin_amdgcn_global_load_lds((const unsigned*)((const char*)(gbase) + (voff)[_i]), (LAS unsigned*)(lds + (bufoff) + ldsw + _i * 8192), 16, 0, 0); } while (0)
#define PG8_LDA(dst, b, h) do { _Pragma("unroll") for (int m = 0; m < 4; ++m) _Pragma("unroll") for (int k = 0; k < 2; ++k) dst[m][k] = *(const LAS bf16x8*)(lds + PG8_SA(b, h) + aoff + m * 2048 + k * 1024); } while (0)
#define PG8_LDB(dst, b, h) do { _Pragma("unroll") for (int n = 0; n < 2; ++n) _Pragma("unroll") for (int k = 0; k < 2; ++k) dst[n][k] = *(const LAS bf16x8*)(lds + PG8_SB(b, h) + boff + n * 2048 + k * 1024); } while (0)
#define PG8_MMA(ai, bj, At, Bt) do { __builtin_amdgcn_s_setprio(1); _Pragma("unroll") for (int m = 0; m < 4; ++m) _Pragma("unroll") for (int n = 0; n < 2; ++n) _Pragma("unroll") for (int k = 0; k < 2; ++k) \
        acc[ai][bj][m][n] = __builtin_amdgcn_mfma_f32_16x16x32_bf16(Bt[n][k], At[m][k], acc[ai][bj][m][n], 0, 0, 0); __builtin_amdgcn_s_setprio(0); } while (0)
#define PG8_WAIT_V(n) asm volatile("s_waitcnt vmcnt(" #n ")" ::: "memory")
#define PG8_WAIT_L(n) asm volatile("s_waitcnt lgkmcnt(" #n ")" ::: "memory")
#define PG8_BAR __builtin_amdgcn_s_barrier()
#define PG8_SCHED __builtin_amdgcn_sched_barrier(0)
    Unit cur, nxt; int ui = 0;
    if (!S.next(0, cur)) return;
    f32x4 acc[2][2][4][2];
#pragma unroll
    for (int a = 0; a < 2; ++a)
#pragma unroll
        for (int b = 0; b < 2; ++b)
#pragma unroll
            for (int m = 0; m < 4; ++m)
#pragma unroll
                for (int n = 0; n < 2; ++n) acc[a][b][m][n] = (f32x4){0.f, 0.f, 0.f, 0.f};
    bf16x8 At[4][2], B0[2][2], B1[2][2];
    const char* cA; const char* cB; S.ptrs(cur, cA, cB);
    PG8_STAGE(PG8_SB(0, 0), cB, voffB); PG8_STAGE(PG8_SB(0, 1), cB + hstepB, voffB); PG8_STAGE(PG8_SA(0, 0), cA, voffA); PG8_STAGE(PG8_SA(0, 1), cA + hstepA, voffA);
    if (wr == 1) PG8_BAR;
    PG8_WAIT_V(2); PG8_BAR;
    PG8_STAGE(PG8_SB(1, 0), cB + kstep, voffB); PG8_STAGE(PG8_SA(1, 0), cA + kstep, voffA); PG8_STAGE(PG8_SB(1, 1), cB + hstepB + kstep, voffB);
    PG8_WAIT_V(6); PG8_BAR;
    for (;;) {
        const bool has_next = S.next(ui + 1, nxt);
        const char* nA = cA; const char* nB = cB; if (has_next) S.ptrs(nxt, nA, nB);
        for (int t = 0; t < nt; t += 2) {
            const bool last = (t == nt - 2);
            const char* a1 = cA + (size_t)(t + 1) * kstep;
            const char* a2 = last ? nA : cA + (size_t)(t + 2) * kstep; const char* b2 = last ? nB : cB + (size_t)(t + 2) * kstep;
            const char* a3 = a2 + kstep; const char* b3 = b2 + kstep;
            PG8_LDB(B0, 0, 0); PG8_LDB(B1, 0, 1); PG8_SCHED; PG8_LDA(At, 0, 0); PG8_STAGE(PG8_SA(1, 1), a1 + hstepA, voffA);
            PG8_WAIT_V(8); PG8_WAIT_L(0); PG8_BAR; PG8_MMA(0, 0, At, B0); PG8_MMA(0, 1, At, B1); PG8_BAR; PG8_SCHED;
            PG8_LDA(At, 0, 1); PG8_STAGE(PG8_SB(0, 0), b2, voffB); PG8_STAGE(PG8_SB(0, 1), b2 + hstepB, voffB); PG8_STAGE(PG8_SA(0, 0), a2, voffA);
            PG8_WAIT_V(8); PG8_WAIT_L(0); PG8_BAR; PG8_MMA(1, 0, At, B0); PG8_MMA(1, 1, At, B1); PG8_BAR; PG8_SCHED;
            PG8_LDB(B0, 1, 0); PG8_LDB(B1, 1, 1); PG8_SCHED; PG8_LDA(At, 1, 0); PG8_STAGE(PG8_SA(0, 1), a2 + hstepA, voffA);
            PG8_WAIT_V(8); PG8_WAIT_L(0); PG8_BAR; PG8_MMA(0, 0, At, B0); PG8_MMA(0, 1, At, B1); PG8_BAR; PG8_SCHED;
            PG8_LDA(At, 1, 1); PG8_STAGE(PG8_SB(1, 0), b3, voffB); PG8_STAGE(PG8_SB(1, 1), b3 + hstepB, voffB); PG8_STAGE(PG8_SA(1, 0), a3, voffA);
            PG8_WAIT_V(8); PG8_WAIT_L(0); PG8_BAR; PG8_MMA(1, 0, At, B0); PG8_MMA(1, 1, At, B1); PG8_BAR; PG8_SCHED;
        }
        if (wr == 0) PG8_BAR;
        E(acc, cur, wr, wc, fr, fq, scr, wid, lane);
        if (!has_next) break;
#pragma unroll
        for (int a = 0; a < 2; ++a)
#pragma unroll
            for (int b = 0; b < 2; ++b)
#pragma unroll
                for (int m = 0; m < 4; ++m)
#pragma unroll
                    for (int n = 0; n < 2; ++n) acc[a][b][m][n] = (f32x4){0.f, 0.f, 0.f, 0.f};
        cur = nxt; cA = nA; cB = nB; ++ui;
        if (wr == 1) PG8_BAR;
    }
    PG8_WAIT_V(0);
    PG8_BAR;
#undef PG8_SA
#undef PG8_SB
#undef PG8_STAGE
#undef PG8_LDA
#undef PG8_LDB
#undef PG8_MMA
#undef PG8_WAIT_V
#undef PG8_WAIT_L
#undef PG8_BAR
#undef PG8_SCHED
}
}

typedef f32x4 AccT[2][2][4][2];
__device__ __forceinline__ void st8(bf16_t* p, const f32x4& v0, const f32x4& v1) {
    u32x4 w; w.x = cvt_pk_bf16(v0[0], v0[1]); w.y = cvt_pk_bf16(v0[2], v0[3]); w.z = cvt_pk_bf16(v1[0], v1[1]); w.w = cvt_pk_bf16(v1[2], v1[3]);
    *(u32x4*)p = w;
}
struct EpiInProj {
    bf16_t* PP; const float* qgain; const float* kgain; const float* bmerge; const f32x2* tab;
    __device__ __forceinline__ void operator()(AccT& acc, const pg8::Unit& u, int wr, int wc, int fr, int fq, LAS unsigned char* scr, int wid, int lane) const {
        const int seg = u.pn >> 2, ct = u.pn & 3;
        bf16_t* O = PP + (size_t)seg * PTOK * 1024;
        const int rt0 = wr * 64 + fr;
        const int cw = wc * 32 + 8 * fq;
        LAS float* P = (LAS float*)scr;
        f32x4 c0[2], c1[2];
        c0[0] = c0[1] = c1[0] = c1[1] = (f32x4){0.f, 0.f, 0.f, 0.f};
        if (seg <= 1) {
#pragma unroll
            for (int ai = 0; ai < 2; ++ai)
#pragma unroll
                for (int m = 0; m < 4; ++m)
#pragma unroll
                    for (int bj = 0; bj < 2; ++bj) {
                        const f32x4 a = acc[ai][bj][m][0], b = acc[ai][bj][m][1];
                        float s = (a[0] * a[0] + a[1] * a[1]) + (a[2] * a[2] + a[3] * a[3]) + (b[0] * b[0] + b[1] * b[1]) + (b[2] * b[2] + b[3] * b[3]);
                        s += __shfl_xor(s, 16); s += __shfl_xor(s, 32);
                        if (fq == 0) P[(ai * 128 + rt0 + m * 16) * 8 + bj * 4 + wc] = s;
                    }
            LDS_WAIT(); __builtin_amdgcn_s_barrier(); asm volatile("" ::: "memory");
            const float* gp = (seg == 0 ? qgain : kgain) + cw;
            c0[0] = c0[1] = *(const f32x4*)gp; c1[0] = c1[1] = *(const f32x4*)(gp + 4);
        } else if (seg >= 8) {
            const float* bp = bmerge + (seg - 8) * 1024 + ct * 256 + cw;
            c0[0] = *(const f32x4*)bp; c1[0] = *(const f32x4*)(bp + 4); c0[1] = *(const f32x4*)(bp + 128); c1[1] = *(const f32x4*)(bp + 132);
        }
#pragma unroll
        for (int ai = 0; ai < 2; ++ai)
#pragma unroll
            for (int m = 0; m < 4; ++m) {
                const int rt = ai * 128 + rt0 + m * 16;
                f32x4 v[2][2];
#pragma unroll
                for (int bj = 0; bj < 2; ++bj) { v[bj][0] = acc[ai][bj][m][0]; v[bj][1] = acc[ai][bj][m][1]; }
                if (seg <= 1) {
                    const float sc = (seg == 0) ? QSCALE : 1.0f;
#pragma unroll
                    for (int bj = 0; bj < 2; ++bj) {
                        const f32x4 p = *(const LAS f32x4*)(P + rt * 8 + bj * 4);
                        const float rs = sc / sqrtf(((p[0] + p[1]) + (p[2] + p[3])) * (1.0f / 128.0f) + EPS);
                        v[bj][0] = v[bj][0] * c0[bj] * rs; v[bj][1] = v[bj][1] * c1[bj] * rs;
                    }
                } else if (seg == 3 || seg == 7) {
#pragma unroll
                    for (int bj = 0; bj < 2; ++bj)
#pragma unroll
                        for (int j = 0; j < 4; ++j) { v[bj][0][j] = v[bj][0][j] * fast_sigmoid(v[bj][0][j]); v[bj][1][j] = v[bj][1][j] * fast_sigmoid(v[bj][1][j]); }
                } else if (seg >= 8) {
#pragma unroll
                    for (int bj = 0; bj < 2; ++bj)
#pragma unroll
                        for (int j = 0; j < 4; ++j) { v[bj][0][j] = fast_sigmoid(v[bj][0][j] + c0[bj][j]); v[bj][1][j] = fast_sigmoid(v[bj][1][j] + c1[bj][j]); }
                } else if (seg == 4 || seg == 5) {
                    const float sc = (seg == 5) ? 0.0625f : 1.0f;
                    const int pos = (u.pm * 256 + rt) & (SEQ - 1);
                    const f32x4* tp = (const f32x4*)(tab + (size_t)pos * 128 + cw);
#pragma unroll
                    for (int n = 0; n < 2; ++n) {
                        const f32x4 t0 = tp[2 * n], t1 = tp[2 * n + 1];
                        const float cs[4] = {t0[0], t0[2], t1[0], t1[2]}, sn[4] = {t0[1], t0[3], t1[1], t1[3]};
#pragma unroll
                        for (int j = 0; j < 4; ++j) {
                            const float x1 = v[0][n][j], x2 = v[1][n][j];
                            v[0][n][j] = (x1 * cs[j] - x2 * sn[j]) * sc; v[1][n][j] = (x1 * sn[j] + x2 * cs[j]) * sc;
                        }
                    }
                }
                bf16_t* rowp = O + (size_t)(u.pm * 256 + rt) * 1024 + ct * 256 + cw;
                st8(rowp, v[0][0], v[0][1]); st8(rowp + 128, v[1][0], v[1][1]);
                if (m & 1) asm volatile("" ::: "memory");
            }
    }
};
template <bool ADD> struct EpiGate {
    const bf16_t* gate; const bf16_t* prev; bf16_t* out;
    __device__ __forceinline__ void operator()(AccT& acc, const pg8::Unit& u, int wr, int wc, int fr, int fq, LAS unsigned char* scr, int wid, int lane) const {
#pragma unroll
        for (int ai = 0; ai < 2; ++ai)
#pragma unroll
            for (int m = 0; m < 4; ++m) {
                const size_t off = (size_t)(u.pm * 256 + ai * 128 + wr * 64 + m * 16 + fr) * 1024 + u.pn * 256 + wc * 32 + 8 * fq;
#pragma unroll
                for (int bj = 0; bj < 2; ++bj) {
                    const u32x4 g = *(const u32x4*)(gate + off + bj * 128);
                    f32x4 v0 = acc[ai][bj][m][0], v1 = acc[ai][bj][m][1];
                    v0[0] *= bf_lo(g.x); v0[1] *= bf_hi(g.x); v0[2] *= bf_lo(g.y); v0[3] *= bf_hi(g.y);
                    v1[0] *= bf_lo(g.z); v1[1] *= bf_hi(g.z); v1[2] *= bf_lo(g.w); v1[3] *= bf_hi(g.w);
                    if (ADD) { const u32x4 p = *(const u32x4*)(prev + off + bj * 128);
                        v0[0] += bf_lo(p.x); v0[1] += bf_hi(p.x); v0[2] += bf_lo(p.y); v0[3] += bf_hi(p.y);
                        v1[0] += bf_lo(p.z); v1[1] += bf_hi(p.z); v1[2] += bf_lo(p.w); v1[3] += bf_hi(p.w); }
                    st8(out + off + bj * 128, v0, v1);
                }
            }
    }
};
struct EpiOut {
    const float* x; float* out;
    __device__ __forceinline__ void operator()(AccT& acc, const pg8::Unit& u, int wr, int wc, int fr, int fq, LAS unsigned char* scr, int wid, int lane) const {
#pragma unroll
        for (int ai = 0; ai < 2; ++ai)
#pragma unroll
            for (int m = 0; m < 4; ++m) {
                const size_t off = (size_t)(u.pm * 256 + ai * 128 + wr * 64 + m * 16 + fr) * 1024 + u.pn * 256 + wc * 32 + 8 * fq;
#pragma unroll
                for (int bj = 0; bj < 2; ++bj)
#pragma unroll
                    for (int n = 0; n < 2; ++n) { const f32x4 xv = *(const f32x4*)(x + off + bj * 128 + 4 * n); *(f32x4*)(out + off + bj * 128 + 4 * n) = xv + acc[ai][bj][m][n]; }
            }
    }
};

#define XB_TMO      128
#define XB_XCNT(j)  (256  + 64 * (j))
#define XB_XSUB(j)  (1280 + 64 * (j))
#define XB_XGEN(j)  (2304 + 64 * (j))
#define XB_TOP      3328
#define XB_TOPGEN   3392
#define XCD_BAR_WORDS 3456
#define XB_SPIN_CAP (1u << 18)
__device__ __forceinline__ unsigned xb_ld(unsigned* p)              { return __hip_atomic_load(p, __ATOMIC_RELAXED, __HIP_MEMORY_SCOPE_AGENT); }
__device__ __forceinline__ unsigned xb_add(unsigned* p, unsigned v) { return __hip_atomic_fetch_add(p, v, __ATOMIC_RELAXED, __HIP_MEMORY_SCOPE_AGENT); }
__device__ __forceinline__ unsigned xb_xcc_id() { return (unsigned)__builtin_amdgcn_s_getreg((3 << 11) | 20) & 0xFu; }
#define XB_SPIN(cond, bar) do { unsigned _sp = 0; while (cond) { __builtin_amdgcn_s_sleep(1); \
    if ((++_sp & 255u) == 0u) { if (xb_ld(&(bar)[XB_TMO])) break; if (_sp > XB_SPIN_CAP) { atomicAdd(&(bar)[XB_TMO], 1u); break; } } } } while (0)
struct XcdBarrier { unsigned* bar; unsigned x; volatile LAS unsigned* st; };
__device__ __forceinline__ XcdBarrier xcd_barrier_post(unsigned* bar, volatile LAS unsigned* st) {
    XcdBarrier b; b.bar = bar; b.x = xb_xcc_id(); b.st = st;
    if (threadIdx.x == 0) (void)xb_add(&bar[XB_XCNT(b.x)], 1u);
    return b;
}
__device__ __forceinline__ void xcd_barrier_complete(unsigned* bar, unsigned x, unsigned& nloc, unsigned& nx) {
    const unsigned G = gridDim.x * gridDim.y * gridDim.z;
    unsigned sum, cnt, mine, sp = 0u;
    for (;;) {
        sum = 0u; cnt = 0u; mine = 0u;
#pragma unroll
        for (unsigned j = 0; j < 16; ++j) { const unsigned c = xb_ld(&bar[XB_XCNT(j)]); sum += c; cnt += (c > 0u) ? 1u : 0u; mine = (j == x) ? c : mine; }
        if (sum == G) break;
        __builtin_amdgcn_s_sleep(1);
        if ((++sp & 255u) == 0u) { if (xb_ld(&bar[XB_TMO])) break; if (sp > XB_SPIN_CAP) { atomicAdd(&bar[XB_TMO], 1u); break; } }
    }
    nloc = mine > 0u ? mine : 1u; nx = cnt > 0u ? cnt : 1u;
}
__device__ __forceinline__ void xcd_barrier(const XcdBarrier& b) {
    asm volatile("s_waitcnt vmcnt(0)" ::: "memory");
    __syncthreads();
    if (threadIdx.x == 0) {
        unsigned* bar = b.bar;
        __builtin_amdgcn_s_waitcnt(0);
        unsigned nloc = b.st[0], nx = b.st[1];
        if (nloc == 0u) { xcd_barrier_complete(bar, b.x, nloc, nx); b.st[0] = nloc; b.st[1] = nx; }
        const unsigned old = xb_add(&bar[XB_XSUB(b.x)], 1u);
        const unsigned gen = old / nloc;
        if (old + 1u == (gen + 1u) * nloc) {
            __builtin_amdgcn_fence(__ATOMIC_RELEASE, "agent");
            asm volatile("s_waitcnt vmcnt(0)" ::: "memory");
            const unsigned og = xb_add(&bar[XB_TOP], 1u);
            const unsigned tg = og / nx;
            if (og + 1u == (tg + 1u) * nx) xb_add(&bar[XB_TOPGEN], 1u);
            else XB_SPIN(xb_ld(&bar[XB_TOPGEN]) == tg, bar);
            __builtin_amdgcn_fence(__ATOMIC_ACQUIRE, "agent");
            xb_add(&bar[XB_XGEN(b.x)], 1u);
            asm volatile("s_waitcnt vmcnt(0)" ::: "memory");
        } else {
            XB_SPIN(xb_ld(&bar[XB_XGEN(b.x)]) == gen, bar);
            __builtin_amdgcn_fence(__ATOMIC_ACQUIRE, "agent");
            asm volatile("s_waitcnt vmcnt(0)" ::: "memory");
        }
    }
    __syncthreads();
}

__device__ __forceinline__ void p0_transpose_item(const float* W, int K, int N, bf16_t* WT, LAS float* scr, int item, int lane) {
    const int nblk = N / 32, kb = item / nblk, nb = item % nblk, k0 = 64 * kb, n0 = 32 * nb;
#pragma unroll 8
    for (int i = 0; i < 32; ++i) { const int kk = 2 * i + (lane >> 5); scr[kk * 33 + (lane & 31)] = W[(size_t)(k0 + kk) * N + n0 + (lane & 31)]; }
    LDS_WAIT(); asm volatile("" ::: "memory");
    const int c = lane & 7;
#pragma unroll
    for (int j = 0; j < 4; ++j) { const int n = (lane >> 3) + 8 * j; const LAS float* s = scr + (8 * c) * 33 + n;
        u32x4 o; o.x = cvt_pk_bf16(s[0 * 33], s[1 * 33]); o.y = cvt_pk_bf16(s[2 * 33], s[3 * 33]); o.z = cvt_pk_bf16(s[4 * 33], s[5 * 33]); o.w = cvt_pk_bf16(s[6 * 33], s[7 * 33]);
        *(u32x4*)(WT + (size_t)(n0 + n) * K + k0 + 8 * c) = o; }
    LDS_WAIT(); asm volatile("" ::: "memory");
}
__device__ __forceinline__ void p0_prologue(LAS unsigned char* lds, int vcu, int G, int wave, int lane, const float* x, const float* ngain, const float* w_in, const float* w_sb, const float* w_ret, const float* w_out,
                                            bf16_t* WinT, bf16_t* WsbT, bf16_t* WretT, bf16_t* WoutT, bf16_t* H, f32x2* tab) {
    asm volatile("" : "+v"(lane));
    LAS float* scr = (LAS float*)(lds + wave * 16384);
    const int gw = vcu * NWAVES + wave, NGW = G * NWAVES;
    constexpr int I_IN = (D / 64) * (INC / 32), I_SQ = (D / 64) * (D / 32);
    for (int it = gw; it < I_IN + 3 * I_SQ; it += NGW) {
        int r = it;
        if (r < I_IN) { p0_transpose_item(w_in, D, INC, WinT, scr, r, lane); continue; } r -= I_IN;
        if (r < I_SQ) { p0_transpose_item(w_sb, D, D, WsbT, scr, r, lane); continue; } r -= I_SQ;
        if (r < I_SQ) { p0_transpose_item(w_ret, D, D, WretT, scr, r, lane); continue; } r -= I_SQ;
        p0_transpose_item(w_out, D, D, WoutT, scr, r, lane);
    }
    f32x4 g[4];
#pragma unroll
    for (int j = 0; j < 4; ++j) g[j] = ((const f32x4*)ngain)[64 * j + lane];
    for (int m = gw; m < NTOK; m += NGW) {
        const f32x4* xr = (const f32x4*)(x + (size_t)m * D) + lane;
        f32x4 v[4]; float s = 0.f;
#pragma unroll
        for (int j = 0; j < 4; ++j) { v[j] = xr[64 * j]; s += (v[j][0] * v[j][0] + v[j][1] * v[j][1]) + (v[j][2] * v[j][2] + v[j][3] * v[j][3]); }
        const float rs = 1.0f / sqrtf(wave_sum(s) * (1.0f / D) + EPS);
        u32x2* o = (u32x2*)(H + (size_t)m * D) + lane;
#pragma unroll
        for (int j = 0; j < 4; ++j) { const f32x4 y = v[j] * rs * g[j]; u32x2 w; w.x = cvt_pk_bf16(y[0], y[1]); w.y = cvt_pk_bf16(y[2], y[3]); o[64 * j] = w; }
    }
    for (int e = (vcu * NWAVES + wave) * 64 + lane; e < SEQ * 128; e += G * NWAVES * 64) {
        const int pos = e >> 7, i = e & 127;
        const float angf = (float)pos * INVF[i];
        const double a = (double)angf;
        const double k = __builtin_rint(a * 0.63661977236758134308);
        double r = __builtin_fma(-k, 1.57079632679489655800, a); r = __builtin_fma(-k, 6.12323399573676603587e-17, r);
        const double r2 = r * r;
        double sp = 1.0 / 6227020800.0; sp = sp * r2 - 1.0 / 39916800.0; sp = sp * r2 + 1.0 / 362880.0; sp = sp * r2 - 1.0 / 5040.0; sp = sp * r2 + 1.0 / 120.0; sp = sp * r2 - 1.0 / 6.0; sp = sp * r2 + 1.0;
        const double sn = r * sp;
        double cp = -1.0 / 87178291200.0; cp = cp * r2 + 1.0 / 479001600.0; cp = cp * r2 - 1.0 / 3628800.0; cp = cp * r2 + 1.0 / 40320.0; cp = cp * r2 - 1.0 / 720.0; cp = cp * r2 + 1.0 / 24.0; cp = cp * r2 - 0.5; cp = cp * r2 + 1.0;
        const int q = (int)((long long)k & 3);
        const double c_ = (q == 0) ? cp : (q == 1) ? -sn : (q == 2) ? -cp : sn;
        const double s_ = (q == 0) ? sn : (q == 1) ? cp : (q == 2) ? -sn : -cp;
        tab[e] = (f32x2){(float)c_, (float)s_};
    }
}

namespace sba {
typedef float f32x16 __attribute__((ext_vector_type(16)));
typedef short v4i16_t __attribute__((ext_vector_type(4)));
constexpr int LDS_K = 0, LDS_V = 32768, LDS_O = 65536;
__device__ __forceinline__ int crow(int r, int hi) { return (r & 3) + 8 * (r >> 2) + 4 * hi; }
__device__ __forceinline__ unsigned offK(int row, int ch) { return (unsigned)(ch * 1024 + ((row ^ (ch & 7)) << 4)); }
__device__ __forceinline__ unsigned offV(int row, int ch) { return (unsigned)(256 * row + 16 * (ch ^ (((row & 3) << 2) | ((row >> 2) & 3)))); }

__device__ __forceinline__ void attn_unit(LAS unsigned char* lds, volatile LAS unsigned* flags, int bl, int h, int qb, bf16_t* QS, const bf16_t* KS, const bf16_t* VS, const bf16_t* GS) {
    int tid = threadIdx.x; asm volatile("" : "+v"(tid));
    const int lane = tid & 63, w = __builtin_amdgcn_readfirstlane(tid >> 6), r = lane & 31, hh = lane >> 5;
    const size_t tok0 = (size_t)bl * SEQ;
    const int qpos = 256 * qb + 32 * w + r;
    const int jtop = 4 * qb + 3, jmine = 4 * qb + (w >> 1);
    bf16x8 qf[8];
    { const bf16_t* qp = QS + (tok0 + qpos) * 1024 + h * SBD + 8 * hh;
#pragma unroll
      for (int ks = 0; ks < 8; ++ks) qf[ks] = *(const bf16x8*)(qp + 16 * ks); }
    const int srow = tid >> 4, sch = tid & 15;
    const bf16_t* kg = KS + (tok0 + srow) * 1024 + h * SBD + sch * 8;
    const bf16_t* vg = VS + (tok0 + srow) * 1024 + h * SBD + sch * 8;
    const unsigned kst0 = offK(srow, sch), kst1 = offK(srow + 32, sch), vst0 = offV(srow, sch), vst1 = offV(srow + 32, sch);
    unsigned kb4[4];
#pragma unroll
    for (int i = 0; i < 4; ++i) kb4[i] = (unsigned)(hh * 1024 + ((r ^ (2 * i + hh)) << 4));
    unsigned vb8[4][2];
    { const int blk = (lane >> 4) & 1, q4 = (lane & 15) >> 2, p = lane & 3;
#pragma unroll
      for (int db = 0; db < 4; ++db)
#pragma unroll
          for (int t = 0; t < 2; ++t) vb8[db][t] = offV(8 * t + 4 * hh + q4, 4 * db + 2 * blk + (p >> 1)) + 8 * (p & 1); }
    f32x16 o[4];
#pragma unroll
    for (int db = 0; db < 4; ++db)
#pragma unroll
        for (int i = 0; i < 16; ++i) o[db][i] = 0.f;
    float Rp = 1.0f; bool wdone = false;
    u32x4 kr0, kr1, vr0, vr1;
    { const size_t go = (size_t)(64 * jtop) * 1024;
      kr0 = *(const u32x4*)(kg + go); kr1 = *(const u32x4*)(kg + go + 32 * 1024); vr0 = *(const u32x4*)(vg + go); vr1 = *(const u32x4*)(vg + go + 32 * 1024); }
    int buf = 0, it = 0;
    for (int jt = jtop; ; --jt, buf ^= 1, ++it) {
        LAS unsigned char* Kb = lds + LDS_K + buf * 16384; LAS unsigned char* Vb = lds + LDS_V + buf * 16384;
        *(LAS u32x4*)(Kb + kst0) = kr0; *(LAS u32x4*)(Kb + kst1) = kr1; *(LAS u32x4*)(Vb + vst0) = vr0; *(LAS u32x4*)(Vb + vst1) = vr1;
        if (jt > 0) { const size_t go = (size_t)(64 * (jt - 1)) * 1024;
            kr0 = *(const u32x4*)(kg + go); kr1 = *(const u32x4*)(kg + go + 32 * 1024); vr0 = *(const u32x4*)(vg + go); vr1 = *(const u32x4*)(vg + go + 32 * 1024); }
        if (lane == 0) flags[(it & 1) * 8 + w] = wdone ? 1u : 0u;
        LDS_WAIT(); __builtin_amdgcn_s_barrier(); asm volatile("" ::: "memory");
        { unsigned all = 1u;
#pragma unroll
          for (int i = 0; i < 8; ++i) all &= flags[(it & 1) * 8 + i];
          if (__builtin_amdgcn_readfirstlane(all)) break; }
        if (jt <= jmine && !wdone) {
            f32x16 p0, p1;
#pragma unroll
            for (int i = 0; i < 16; ++i) { p0[i] = 0.f; p1[i] = 0.f; }
#pragma unroll
            for (int ks = 0; ks < 8; ++ks) {
                const bf16x8 k0 = *(const LAS bf16x8*)(Kb + kb4[ks & 3] + 2048 * ks);
                const bf16x8 k1 = *(const LAS bf16x8*)(Kb + kb4[ks & 3] + 2048 * ks + 512);
                p0 = __builtin_amdgcn_mfma_f32_32x32x16_bf16(k0, qf[ks], p0, 0, 0, 0);
                p1 = __builtin_amdgcn_mfma_f32_32x32x16_bf16(k1, qf[ks], p1, 0, 0, 0);
            }
            if (jt >= 4 * qb) {
                const int kbase = 64 * jt + 4 * hh;
#pragma unroll
                for (int i = 0; i < 16; ++i) { const int key = kbase + (i & 3) + 8 * (i >> 2); if (key >= qpos) p0[i] = -INFINITY; if (key + 32 >= qpos) p1[i] = -INFINITY; }
            }
            float wgt[2][16]; float T[2][4], Pz[2][4];
#pragma unroll
            for (int kb = 0; kb < 2; ++kb) {
#pragma unroll
                for (int i = 0; i < 16; ++i) { const float y = kb ? p1[i] : p0[i]; const float kp = __builtin_amdgcn_rcpf(1.0f + __builtin_amdgcn_exp2f(y)); wgt[kb][i] = kp; }
            }
            float c1[2][4], c2[2][4];
#pragma unroll
            for (int kb = 0; kb < 2; ++kb)
#pragma unroll
                for (int g = 0; g < 4; ++g) {
                    c1[kb][g] = wgt[kb][4 * g + 3] * wgt[kb][4 * g + 2]; c2[kb][g] = c1[kb][g] * wgt[kb][4 * g + 1];
                    const float M = c2[kb][g] * wgt[kb][4 * g];
                    const auto rr = __builtin_amdgcn_permlane32_swap(__float_as_uint(M), __float_as_uint(M), false, false);
                    const float mlo = __uint_as_float(rr[0]), mhi = __uint_as_float(rr[1]);
                    T[kb][g] = mlo * mhi; Pz[kb][g] = hh ? 1.0f : mhi;
                }
            float X = Rp;
#pragma unroll
            for (int kb = 1; kb >= 0; --kb)
#pragma unroll
                for (int g = 3; g >= 0; --g) {
                    const float off = X * Pz[kb][g]; X *= T[kb][g];
                    const float k3 = wgt[kb][4 * g + 3], k2 = wgt[kb][4 * g + 2], k1 = wgt[kb][4 * g + 1], k0 = wgt[kb][4 * g];
                    wgt[kb][4 * g + 3] = (1.0f - k3) * off;
                    wgt[kb][4 * g + 2] = (1.0f - k2) * (off * k3);
                    wgt[kb][4 * g + 1] = (1.0f - k1) * (off * c1[kb][g]);
                    wgt[kb][4 * g]     = (1.0f - k0) * (off * c2[kb][g]);
                }
            Rp = X;
            u32x4 pa[4];
#pragma unroll
            for (int s = 0; s < 4; ++s) { const int kb = s >> 1, b8 = 8 * (s & 1);
                pa[s].x = cvt_pk_bf16(wgt[kb][b8], wgt[kb][b8 + 1]); pa[s].y = cvt_pk_bf16(wgt[kb][b8 + 2], wgt[kb][b8 + 3]);
                pa[s].z = cvt_pk_bf16(wgt[kb][b8 + 4], wgt[kb][b8 + 5]); pa[s].w = cvt_pk_bf16(wgt[kb][b8 + 6], wgt[kb][b8 + 7]); }
#pragma unroll
            for (int s = 0; s < 4; ++s)
#pragma unroll
                for (int db = 0; db < 4; ++db) {
                    const v4i16_t lo = __builtin_amdgcn_ds_read_tr16_b64_v4i16((LAS v4i16_t*)(Vb + vb8[db][0] + 4096 * s));
                    const v4i16_t hi = __builtin_amdgcn_ds_read_tr16_b64_v4i16((LAS v4i16_t*)(Vb + vb8[db][1] + 4096 * s));
                    const bf16x8 vf = (bf16x8){lo[0], lo[1], lo[2], lo[3], hi[0], hi[1], hi[2], hi[3]};
                    o[db] = __builtin_amdgcn_mfma_f32_32x32x16_bf16(__builtin_bit_cast(bf16x8, pa[s]), vf, o[db], 0, 0, 0);
                }
            wdone = __all(Rp < 1.17549435e-38f);
        }
        if (jt == 0) break;
    }
    LAS bf16_t* stg = (LAS bf16_t*)(lds + LDS_O + w * 8192);
#pragma unroll
    for (int db = 0; db < 4; ++db)
#pragma unroll
        for (int i = 0; i < 16; ++i) stg[crow(i, hh) * 128 + 32 * db + r] = (bf16_t)(cvt_pk_bf16(o[db][i], 0.f) & 0xffffu);
    LDS_WAIT(); asm volatile("" ::: "memory");
#pragma unroll
    for (int i = 0; i < 8; ++i) {
        const int row = 4 * i + (lane >> 4), ch = lane & 15;
        const u32x4 ov = *(const LAS u32x4*)(stg + row * 128 + ch * 8);
        const size_t go = (tok0 + 256 * qb + 32 * w + row) * 1024 + h * SBD + ch * 8;
        const u32x4 gv = *(const u32x4*)(GS + go);
        u32x4 res;
        res.x = cvt_pk_bf16(bf_lo(ov.x) * bf_lo(gv.x), bf_hi(ov.x) * bf_hi(gv.x)); res.y = cvt_pk_bf16(bf_lo(ov.y) * bf_lo(gv.y), bf_hi(ov.y) * bf_hi(gv.y));
        res.z = cvt_pk_bf16(bf_lo(ov.z) * bf_lo(gv.z), bf_hi(ov.z) * bf_hi(gv.z)); res.w = cvt_pk_bf16(bf_lo(ov.w) * bf_lo(gv.w), bf_hi(ov.w) * bf_hi(gv.w));
        *(u32x4*)(QS + go) = res;
    }
    LDS_WAIT(); __builtin_amdgcn_s_barrier(); asm volatile("" ::: "memory");
}
__device__ __forceinline__ void attn_phase(LAS unsigned char* lds, volatile LAS unsigned* flags, int G, int bx, bf16_t* QS, const bf16_t* KS, const bf16_t* VS, const bf16_t* GS) {
    for (int u = bx; u < 2 * SBH * 32; u += G) { const int qb = u & 31, bh = u >> 5; attn_unit(lds, flags, bh >> 3, bh & 7, qb, QS, KS, VS, GS); }
}
}

__device__ __forceinline__ void naive_attention(int gw, int NGW, int lane, bf16_t* QS, const bf16_t* KS, const bf16_t* VS, const bf16_t* GS) {
    asm volatile("" : "+v"(lane));
    for (int task = gw; task < 2 * SBH * SEQ; task += NGW) {
        const int t = task & (SEQ - 1), bh = task >> 13, h = bh & 7, bl = bh >> 3;
        const size_t rowq = (size_t)(bl * SEQ + t) * 1024 + h * SBD + 2 * lane;
        const unsigned qw = *(const unsigned*)(QS + rowq);
        const float q0 = bf_lo(qw), q1 = bf_hi(qw);
        float a0 = 0.f, a1 = 0.f, run = 0.f;
        const bf16_t* kb = KS + (size_t)(bl * SEQ) * 1024 + h * SBD + 2 * lane;
        const bf16_t* vb = VS + (size_t)(bl * SEQ) * 1024 + h * SBD + 2 * lane;
        for (int s = t - 1; s >= 0; --s) {
            const unsigned kw = *(const unsigned*)(kb + (size_t)s * 1024);
            const unsigned vw = *(const unsigned*)(vb + (size_t)s * 1024);
            const float y = wave_sum(q0 * bf_lo(kw) + q1 * bf_hi(kw));
            const float z = y * LN2F;
            const float sp = fmaxf(z, 0.f) + log1pf(expf(-fabsf(z)));
            const float w = expf((z - sp) + run);
            run -= sp;
            a0 += w * bf_lo(vw); a1 += w * bf_hi(vw);
            if (run < -110.f) break;
        }
        const unsigned gwd = *(const unsigned*)(GS + rowq);
        *(unsigned*)(QS + rowq) = cvt_pk_bf16(a0 * bf_lo(gwd), a1 * bf_hi(gwd));
    }
}
__device__ __forceinline__ void naive_retention(int gw, int NGW, int lane, bf16_t* RQ, const bf16_t* RK, const bf16_t* RV, const bf16_t* GR, const float* rgain) {
    asm volatile("" : "+v"(lane));
    for (int task = gw; task < 2 * RH * SEQ; task += NGW) {
        const int t = task & (SEQ - 1), bh = task >> 13, h = bh & 3, bl = bh >> 2;
        const size_t rowq = (size_t)(bl * SEQ + t) * 1024 + h * RD + 4 * lane;
        const u32x2 qw = *(const u32x2*)(RQ + rowq);
        const float q0 = bf_lo(qw.x), q1 = bf_hi(qw.x), q2 = bf_lo(qw.y), q3 = bf_hi(qw.y);
        float a0 = 0.f, a1 = 0.f, a2 = 0.f, a3 = 0.f;
        const bf16_t* kb = RK + (size_t)(bl * SEQ) * 1024 + h * RD + 4 * lane;
        const bf16_t* vb = RV + (size_t)(bl * SEQ) * 1024 + h * RD + 4 * lane;
        const float l2g = log2gamma(h);
        const int send = (t | 63) + 1;
#pragma unroll 4
        for (int s = 0; s < send; ++s) {
            const u32x2 kw = *(const u32x2*)(kb + (size_t)s * 1024);
            const u32x2 vw = *(const u32x2*)(vb + (size_t)s * 1024);
            const float d = wave_sum((q0 * bf_lo(kw.x) + q1 * bf_hi(kw.x)) + (q2 * bf_lo(kw.y) + q3 * bf_hi(kw.y)));
            const int dist = t > s ? t - s : s - t;
            const float w = d * __builtin_amdgcn_exp2f(l2g * (float)dist);
            a0 += w * bf_lo(vw.x); a1 += w * bf_hi(vw.x); a2 += w * bf_lo(vw.y); a3 += w * bf_hi(vw.y);
        }
        const float ss = wave_sum((a0 * a0 + a1 * a1) + (a2 * a2 + a3 * a3));
        const float rs = 1.0f / sqrtf(ss * (1.0f / RD) + EPS);
        const f32x4 g = *(const f32x4*)(rgain + h * RD + 4 * lane);
        const u32x2 gw2 = *(const u32x2*)(GR + rowq);
        u32x2 o; o.x = cvt_pk_bf16(a0 * rs * g[0] * bf_lo(gw2.x), a1 * rs * g[1] * bf_hi(gw2.x)); o.y = cvt_pk_bf16(a2 * rs * g[2] * bf_lo(gw2.y), a3 * rs * g[3] * bf_hi(gw2.y));
        *(u32x2*)(RQ + rowq) = o;
    }
}

constexpr int NPHASE = 1 + 5 * NPASS;
struct Args { const float* in[10]; float* out; unsigned char* ws; int ph_lo, ph_hi; };
__device__ __forceinline__ unsigned char* lds_ptr(volatile LAS unsigned* tabl, int i) {
    const unsigned lo = __builtin_amdgcn_readfirstlane(tabl[2 * i]), hi = __builtin_amdgcn_readfirstlane(tabl[2 * i + 1]);
    return (unsigned char*)(((unsigned long long)hi << 32) | lo);
}
__global__ void __launch_bounds__(NWAVES * 64, 2) fwd(Args args) {
    extern __shared__ __attribute__((aligned(16))) unsigned char lds_raw[];
    LAS unsigned char* lds = (LAS unsigned char*)lds_raw;
    volatile LAS unsigned* MISC = (volatile LAS unsigned*)(lds + MISC_OFF);
    const int tid = threadIdx.x, lane = tid & 63, wave = __builtin_amdgcn_readfirstlane(tid >> 6);
    if (tid < 32) MISC[tid] = 0u;
    if (tid < 12) { const unsigned long long pv = (tid < 10) ? (unsigned long long)args.in[tid] : (tid == 10) ? (unsigned long long)args.out : (unsigned long long)args.ws;
        MISC[32 + 2 * tid] = (unsigned)pv; MISC[32 + 2 * tid + 1] = (unsigned)(pv >> 32); }
    __syncthreads();
    volatile LAS unsigned* PT = MISC + 32;
#define P_IN(i) ((const float*)lds_ptr(PT, (i)))
#define P_OUT() ((float*)lds_ptr(PT, 10))
#define P_WS() (lds_ptr(PT, 11))
    const int lo = args.ph_lo, hi = args.ph_hi;
    const bool use_bar = (hi - lo) > 1;
    XcdBarrier bar; bar.bar = (unsigned*)(args.ws + WS_CTL) + CW_BAR; bar.x = 0; bar.st = MISC + 8;
    if (use_bar) bar = xcd_barrier_post((unsigned*)(args.ws + WS_CTL) + CW_BAR, MISC + 8);
#define IN(k) (lo <= (k) && (k) < hi)
#define BOTH(k) (IN(k) && IN((k) + 1))
#define GRID_BAR() xcd_barrier(bar)
#define VCU() ((int)((gridDim.x % 8 == 0) ? (blockIdx.x % 8) * (gridDim.x / 8) + blockIdx.x / 8 : blockIdx.x))
    LAS unsigned char* scr = lds + SCR_OFF;

    if (IN(0)) {
        unsigned char* ws = P_WS();
        p0_prologue(lds, VCU(), gridDim.x, wave, lane, P_IN(0), P_IN(1), P_IN(2), P_IN(7), P_IN(8), P_IN(9),
                    (bf16_t*)(ws + WS_WIN), (bf16_t*)(ws + WS_WSB), (bf16_t*)(ws + WS_WRET), (bf16_t*)(ws + WS_WOUT), (bf16_t*)(ws + WS_H), (f32x2*)(ws + WS_TAB));
        if (BOTH(0)) GRID_BAR();
    }

    _Pragma("unroll") for (int p = 0; p < NPASS; ++p) {
        const int pb = 1 + 5 * p;
        if (IN(pb + 0)) {
            unsigned char* ws = P_WS();
            pg8::StaticOrder S; S.init(PTOK, INC, gridDim.x, blockIdx.x, ws + WS_H + (size_t)p * ARR, ws + WS_WIN, D, D);
            EpiInProj E{(bf16_t*)(ws + WS_PP), P_IN(4), P_IN(5), P_IN(3), (const f32x2*)(ws + WS_TAB)};
            pg8::gemm_phase(lds, scr, D, D, D, S, E);
            if (BOTH(pb + 0)) GRID_BAR();
        }
        if (IN(pb + 1)) {
            unsigned char* ws = P_WS();
            const int gw = VCU() * NWAVES + wave, NGW = gridDim.x * NWAVES;
            bf16_t* PPb = (bf16_t*)(ws + WS_PP);
            sba::attn_phase(lds, (volatile LAS unsigned*)scr, gridDim.x, blockIdx.x, PPb + A_QS * (size_t)PTOK * 1024, PPb + A_KS * (size_t)PTOK * 1024, PPb + A_VS * (size_t)PTOK * 1024, PPb + A_GS * (size_t)PTOK * 1024);
            naive_retention(gw, NGW, lane, PPb + A_RQ * (size_t)PTOK * 1024, PPb + A_RK * (size_t)PTOK * 1024, PPb + A_RV * (size_t)PTOK * 1024, PPb + A_GR * (size_t)PTOK * 1024, P_IN(6));
            if (BOTH(pb + 1)) GRID_BAR();
        }
        if (IN(pb + 2)) {
            unsigned char* ws = P_WS();
            pg8::StaticOrder S; S.init(PTOK, D, gridDim.x, blockIdx.x, ws + WS_PP + A_QS * ARR, ws + WS_WSB, D, D);
            EpiGate<false> E{(const bf16_t*)(ws + WS_PP + A_MA * ARR), nullptr, (bf16_t*)(ws + WS_T1)};
            pg8::gemm_phase(lds, scr, D, D, D, S, E);
            if (BOTH(pb + 2)) GRID_BAR();
        }
        if (IN(pb + 3)) {
            unsigned char* ws = P_WS();
            pg8::StaticOrder S; S.init(PTOK, D, gridDim.x, blockIdx.x, ws + WS_PP + A_RQ * ARR, ws + WS_WRET, D, D);
            EpiGate<true> E{(const bf16_t*)(ws + WS_PP + A_MB * ARR), (const bf16_t*)(ws + WS_T1), (bf16_t*)(ws + WS_MG)};
            pg8::gemm_phase(lds, scr, D, D, D, S, E);
            if (BOTH(pb + 3)) GRID_BAR();
        }
        if (IN(pb + 4)) {
            unsigned char* ws = P_WS();
            pg8::StaticOrder S; S.init(PTOK, D, gridDim.x, blockIdx.x, ws + WS_MG, ws + WS_WOUT, D, D);
            EpiOut E{P_IN(0) + (size_t)p * PTOK * D, P_OUT() + (size_t)p * PTOK * D};
            pg8::gemm_phase(lds, scr, D, D, D, S, E);
            if (BOTH(pb + 4)) GRID_BAR();
        }
    }
#undef IN
#undef BOTH
#undef GRID_BAR
}

extern "C" void kernel_launch(void* const* d_in, const int* in_sizes, int n_in, void* d_out, int out_size, void* d_ws, size_t ws_size, hipStream_t stream) {
    static int grid = 0;
    if (grid == 0) {
        if (n_in != 10 || in_sizes[0] != NTOK * D || out_size != NTOK * D || ws_size < WS_END) { fprintf(stderr, "kernel_launch: unexpected shapes / workspace (%zu < %zu)\n", ws_size, (size_t)WS_END); grid = -1; return; }
        int dev = 0, cus = 0;
        if (hipGetDevice(&dev) != hipSuccess || hipDeviceGetAttribute(&cus, hipDeviceAttributeMultiprocessorCount, dev) != hipSuccess) { grid = -1; return; }
        if (hipFuncSetAttribute((const void*)fwd, hipFuncAttributeMaxDynamicSharedMemorySize, LDS_BYTES) != hipSuccess) { fprintf(stderr, "kernel_launch: hipFuncSetAttribute failed\n"); grid = -1; return; }
        (void)hipGetLastError();
        grid = cus;
    }
    if (grid < 0) return;
    (void)hipMemsetAsync((char*)d_ws + WS_CTL, 0, CTL_ZERO_BYTES, stream);
    Args a{};
    for (int i = 0; i < 10; ++i) a.in[i] = (const float*)d_in[i];
    a.out = (float*)d_out; a.ws = (unsigned char*)d_ws;
    a.ph_lo = 0; a.ph_hi = NPHASE;
    hipLaunchKernelGGL(fwd, dim3(grid), dim3(NWAVES * 64), LDS_BYTES, stream, a);
}
```

```cpp
#include <hip/hip_runtime.h>
#include <cstdio>
#include <cstdint>

#define LAS __attribute__((address_space(3)))
#define GAS __attribute__((address_space(1)))
typedef unsigned short bf16_t;
typedef short bf16x8 __attribute__((ext_vector_type(8)));
typedef float f32x4 __attribute__((ext_vector_type(4)));
typedef float f32x2 __attribute__((ext_vector_type(2)));
typedef unsigned u32x4 __attribute__((ext_vector_type(4)));
typedef unsigned u32x2 __attribute__((ext_vector_type(2)));

constexpr int D = 1024, BATCH = 4, SEQ = 8192, NTOK = BATCH * SEQ;
constexpr int NPASS = 2, PTOK = NTOK / NPASS;
constexpr int INC = 10240;
constexpr int SBH = 8, SBD = 128, RH = 4, RD = 256;
constexpr float EPS = 1e-6f;
constexpr float QSCALE = 0.12751743082459868f;
constexpr float LN2F = 0.6931471805599453f;
constexpr size_t MiB = 1u << 20;
constexpr size_t WS_CTL = 0, CTL_ZERO_BYTES = 1 * MiB;
constexpr size_t WS_WIN = 1 * MiB, WS_WSB = 21 * MiB, WS_WRET = 23 * MiB, WS_WOUT = 25 * MiB, WS_TAB = 27 * MiB, WS_H = 35 * MiB;
constexpr size_t ARR = (size_t)PTOK * 1024 * 2;
constexpr size_t WS_QS = 99 * MiB, WS_KS = WS_QS + ARR, WS_VS = WS_KS + ARR, WS_GS = WS_VS + ARR, WS_RK = WS_GS + ARR, WS_GR = WS_RK + ARR;
constexpr size_t WS_A2 = WS_GR + ARR, WS_B2 = WS_A2 + 2 * ARR, WS_MA = WS_B2 + 2 * ARR, WS_MB = WS_MA + ARR, WS_END = WS_MB + ARR;
constexpr size_t WS_T1 = WS_KS, WS_MG = WS_VS, WS_OB = WS_RK;
constexpr size_t DO_KT = 0, DO_U = ARR;
constexpr int RUNITS = 2 * RH * 32;
constexpr int CW_BAR = 4096;
constexpr int RING_BYTES = 131072, SCR_OFF = RING_BYTES, SCR_BYTES = 8192, MISC_OFF = SCR_OFF + SCR_BYTES, LDS_BYTES = 147456;
constexpr int NWAVES = 8;

__device__ const float INVF[128] = {
1.0f, 0.930572033f, 0.865964353f, 0.805842161f, 0.749894261f, 0.697830617f, 0.649381638f, 0.604296386f, 0.562341332f, 0.523299098f, 0.486967534f, 0.453158379f, 0.421696514f, 0.392418981f, 0.365174115f, 0.339820832f, 0.316227764f, 0.294272691f, 0.273841977f, 0.254829675f, 0.237137377f, 0.220673412f, 0.2053525f, 0.191095307f, 0.177827939f, 0.165481716f, 0.153992653f, 0.143301249f, 0.133352131f, 0.124093778f, 0.115478203f, 0.107460782f, 0.100000001f, 0.0930572078f, 0.0865964293f, 0.0805842131f, 0.0749894157f, 0.0697830617f, 0.0649381652f, 0.0604296401f, 0.0562341325f, 0.0523299128f, 0.0486967526f, 0.0453158356f, 0.0421696529f, 0.0392418951f, 0.0365174115f, 0.0339820832f, 0.0316227749f, 0.0294272713f, 0.0273841973f, 0.0254829675f, 0.0237137377f, 0.0220673401f, 0.0205352511f, 0.0191095285f, 0.0177827943f, 0.0165481698f, 0.0153992651f, 0.0143301254f, 0.0133352149f, 0.0124093778f, 0.0115478206f, 0.0107460786f, 0.00999999978f, 0.00930572022f, 0.00865964312f, 0.00805842225f, 0.00749894185f, 0.00697830599f, 0.00649381615f, 0.00604296383f, 0.00562341325f, 0.00523299119f, 0.00486967526f, 0.00453158328f, 0.00421696482f, 0.0039241896f, 0.00365174119f, 0.00339820841f, 0.00316227763f, 0.00294272718f, 0.00273841969f, 0.00254829694f, 0.00237137359f, 0.00220673415f, 0.00205352483f, 0.00191095297f, 0.00177827943f, 0.00165481714f, 0.00153992651f, 0.00143301254f, 0.00133352145f, 0.00124093774f, 0.0011547819f, 0.00107460783f, 0.00100000005f, 0.000930572045f, 0.000865964335f, 0.000805842166f, 0.000749894243f, 0.000697830576f, 0.000649381662f, 0.000604296394f, 0.000562341302f, 0.000523299095f, 0.000486967532f, 0.000453158369f, 0.000421696517f, 0.000392418966f, 0.000365174143f, 0.000339820836f, 0.000316227757f, 0.000294272701f, 0.000273841957f, 0.000254829676f, 0.00023713737f, 0.000220673406f, 0.00020535251f, 0.0001910953f, 0.00017782794f, 0.000165481717f, 0.000153992645f, 0.000143301251f, 0.00013335215f, 0.000124093771f, 0.0001154782f, 0.000107460786f };
__device__ __forceinline__ float log2gamma(int h) { return h == 0 ? -0.04580368961312479f : h == 1 ? -0.02272007650008353f : h == 2 ? -0.011315313227834146f : -0.005646563141142063f; }

__device__ __forceinline__ unsigned cvt_pk_bf16(float lo, float hi) { unsigned r; asm volatile("v_cvt_pk_bf16_f32 %0, %1, %2" : "=v"(r) : "v"(lo), "v"(hi)); return r; }
__device__ __forceinline__ float bf_lo(unsigned w) { return __uint_as_float(w << 16); }
__device__ __forceinline__ float bf_hi(unsigned w) { return __uint_as_float(w & 0xffff0000u); }
__device__ __forceinline__ float wave_sum(float v) {
#pragma unroll
    for (int o = 1; o < 64; o <<= 1) v += __shfl_xor(v, o);
    return v;
}
__device__ __forceinline__ float fast_sigmoid(float v) { return __builtin_amdgcn_rcpf(1.0f + __builtin_amdgcn_exp2f(-1.4426950408889634f * v)); }
__device__ __forceinline__ int fresh_lane() { int z = 0; asm volatile("" : "+v"(z)); return (int)__builtin_amdgcn_mbcnt_hi(~0u, __builtin_amdgcn_mbcnt_lo(~0u, (unsigned)z)); }
__device__ __forceinline__ float sum_fq(float s) {
    s += __builtin_bit_cast(float, __builtin_amdgcn_ds_swizzle(__builtin_bit_cast(int, s), 0x401F));
    const auto rr = __builtin_amdgcn_permlane32_swap(__float_as_uint(s), __float_as_uint(s), false, false);
    return __uint_as_float(rr[0]) + __uint_as_float(rr[1]);
}
#define LDS_WAIT() asm volatile("s_waitcnt lgkmcnt(0)" ::: "memory")
#define VM_WAIT() asm volatile("s_waitcnt vmcnt(0)" ::: "memory")

namespace pg8 {
constexpr int BM = 256, BK = 64, HALF = 128, HTB = HALF * BK * 2, STAGE_BYTES = 8 * HTB;
__host__ __device__ __forceinline__ int lds_byte(int r, int c) { const int st = (r >> 4) * 2 + (c >> 5), rr = r & 15, cc = c & 31, ob = rr * 64 + cc * 2; return st * 1024 + (ob ^ (((ob >> 9) & 1) << 5)); }
__host__ __device__ __forceinline__ void stage_rc(int b, int& R, int& C) { const int st = b / 1024, sb = b % 1024, swz = sb ^ (((sb >> 9) & 1) << 5); R = (st >> 1) * 16 + swz / 64; C = (st & 1) * 32 + (swz % 64) / 2; }
__host__ __device__ __forceinline__ int perm32(int rho) { const int n = rho >> 4, i = rho & 15; return 8 * (i >> 2) + 4 * n + (i & 3); }
struct Unit { int pm, pn; };

struct StaticOrder {
    int nM, nN, nwg, G, c; const char* A; const char* B; size_t tA, tB;
    __device__ void init(int M, int N, int G_, int c_, const void* A_, const void* B_, int lda, int ldb) { nM = M / BM; nN = N / BM; nwg = nM * nN; G = G_; c = c_; A = (const char*)A_; B = (const char*)B_; tA = (size_t)BM * lda * 2; tB = (size_t)BM * ldb * 2; }
    __device__ bool next(int i, Unit& u) const {
        const long L = (long)i * G + c; if (L >= nwg) return false;
        int wgid = (int)L; { const int q = nwg / 8, r = nwg % 8, xcd = wgid % 8, off = wgid / 8; wgid = (xcd < r ? xcd * (q + 1) : r * (q + 1) + (xcd - r) * q) + off; }
        const int nig = 8 * nN, gid = wgid / nig, fm = gid * 8, gsz = (nM - fm) < 8 ? (nM - fm) : 8;
        u.pm = fm + ((wgid % nig) % gsz); u.pn = (wgid % nig) / gsz; return true;
    }
    __device__ __forceinline__ void ptrs(const Unit& u, const char*& a, const char*& b) const { a = A + (size_t)u.pm * tA; b = B + (size_t)u.pn * tB; }
};

template <class Epi, class Sched>
__device__ __forceinline__ void gemm_phase(LAS unsigned char* lds, LAS unsigned char* scr, int wid, const int K, const int lda, const int ldb, const Sched& S, const Epi& E) {
    asm volatile("" : "+s"(wid));
    const int lane = fresh_lane(), tid = wid * 64 + lane;
    const int wr = wid >> 2, wc = wid & 3, fr = lane & 15, fq = lane >> 4;
    const int nt = K / BK;
    unsigned voffA[2], voffB[2];
#pragma unroll
    for (int i = 0; i < 2; ++i) { int R, C; stage_rc(tid * 16 + i * 8192, R, C); const int Rb = (R & ~31) + perm32(R & 31);
        voffA[i] = (unsigned)(R * lda + C) * 2u; voffB[i] = (unsigned)(Rb * ldb + C) * 2u; }
    const size_t kstep = (size_t)(BK * 2);
    const size_t hstepA = (size_t)HALF * lda * 2, hstepB = (size_t)HALF * ldb * 2;
    const unsigned ldsw = (unsigned)wid * 1024u;
    const int aoff = lds_byte(wr * 64 + fr, fq * 8), boff = lds_byte(wc * 32 + fr, fq * 8);
#define PG8_SA(b, h) (((b) * 2 + (h)) * HTB)
#define PG8_SB(b, h) ((4 + (b) * 2 + (h)) * HTB)
#define PG8_STAGE(bufoff, gbase, voff) do { _Pragma("unroll") for (int _i = 0; _i < 2; ++_i) \
        __builtin_amdgcn_global_load_lds((const unsigned*)((const char*)(gbase) + (voff)[_i]), (LAS unsigned*)(lds + (bufoff) + ldsw + _i * 8192), 16, 0, 0); } while (0)
#define PG8_LDA(dst, b, h) do { _Pragma("unroll") for (int m = 0; m < 4; ++m) _Pragma("unroll") for (int k = 0; k < 2; ++k) dst[m][k] = *(const LAS bf16x8*)(lds + PG8_SA(b, h) + aoff + m * 2048 + k * 1024); } while (0)
#define PG8_LDB(dst, b, h) do { _Pragma("unroll") for (int n = 0; n < 2; ++n) _Pragma("unroll") for (int k = 0; k < 2; ++k) dst[n][k] = *(const LAS bf16x8*)(lds + PG8_SB(b, h) + boff + n * 2048 + k * 1024); } while (0)
#define PG8_MMA(ai, bj, At, Bt) do { __builtin_amdgcn_s_setprio(1); _Pragma("unroll") for (int m = 0; m < 4; ++m) _Pragma("unroll") for (int n = 0; n < 2; ++n) _Pragma("unroll") for (int k = 0; k < 2; ++k) \
        acc[ai][bj][m][n] = __builtin_amdgcn_mfma_f32_16x16x32_bf16(Bt[n][k], At[m][k], acc[ai][bj][m][n], 0, 0, 0); __builtin_amdgcn_s_setprio(0); } while (0)
#define PG8_WAIT_V(n) asm volatile("s_waitcnt vmcnt(" #n ")" ::: "memory")
#define PG8_WAIT_L(n) asm volatile("s_waitcnt lgkmcnt(" #n ")" ::: "memory")
#define PG8_BAR __builtin_amdgcn_s_barrier()
#define PG8_SCHED __builtin_amdgcn_sched_barrier(0)
    Unit cur, nxt; int ui = 0;
    if (!S.next(0, cur)) return;
    f32x4 acc[2][2][4][2];
#pragma unroll
    for (int a = 0; a < 2; ++a)
#pragma unroll
        for (int b = 0; b < 2; ++b)
#pragma unroll
            for (int m = 0; m < 4; ++m)
#pragma unroll
                for (int n = 0; n < 2; ++n) acc[a][b][m][n] = (f32x4){0.f, 0.f, 0.f, 0.f};
    bf16x8 At[4][2], B0[2][2], B1[2][2];
    const char* cA; const char* cB; S.ptrs(cur, cA, cB);
    PG8_STAGE(PG8_SB(0, 0), cB, voffB); PG8_STAGE(PG8_SB(0, 1), cB + hstepB, voffB); PG8_STAGE(PG8_SA(0, 0), cA, voffA); PG8_STAGE(PG8_SA(0, 1), cA + hstepA, voffA);
    if (wr == 1) PG8_BAR;
    PG8_WAIT_V(2); PG8_BAR;
    PG8_STAGE(PG8_SB(1, 0), cB + kstep, voffB); PG8_STAGE(PG8_SA(1, 0), cA + kstep, voffA); PG8_STAGE(PG8_SB(1, 1), cB + hstepB + kstep, voffB);
    PG8_WAIT_V(6); PG8_BAR;
    for (;;) {
        const bool has_next = S.next(ui + 1, nxt);
        const char* nA = cA; const char* nB = cB; if (has_next) S.ptrs(nxt, nA, nB);
        for (int t = 0; t < nt; t += 2) {
            const bool last = (t == nt - 2);
            const char* a1 = cA + (size_t)(t + 1) * kstep;
            const char* a2 = last ? nA : cA + (size_t)(t + 2) * kstep; const char* b2 = last ? nB : cB + (size_t)(t + 2) * kstep;
            const char* a3 = a2 + kstep; const char* b3 = b2 + kstep;
            PG8_LDB(B0, 0, 0); PG8_LDB(B1, 0, 1); PG8_SCHED; PG8_LDA(At, 0, 0); PG8_STAGE(PG8_SA(1, 1), a1 + hstepA, voffA);
            PG8_WAIT_V(8); PG8_WAIT_L(0); PG8_BAR; PG8_MMA(0, 0, At, B0); PG8_MMA(0, 1, At, B1); PG8_BAR; PG8_SCHED;
            PG8_LDA(At, 0, 1); PG8_STAGE(PG8_SB(0, 0), b2, voffB); PG8_STAGE(PG8_SB(0, 1), b2 + hstepB, voffB); PG8_STAGE(PG8_SA(0, 0), a2, voffA);
            PG8_WAIT_V(8); PG8_WAIT_L(0); PG8_BAR; PG8_MMA(1, 0, At, B0); PG8_MMA(1, 1, At, B1); PG8_BAR; PG8_SCHED;
            PG8_LDB(B0, 1, 0); PG8_LDB(B1, 1, 1); PG8_SCHED; PG8_LDA(At, 1, 0); PG8_STAGE(PG8_SA(0, 1), a2 + hstepA, voffA);
            PG8_WAIT_V(8); PG8_WAIT_L(0); PG8_BAR; PG8_MMA(0, 0, At, B0); PG8_MMA(0, 1, At, B1); PG8_BAR; PG8_SCHED;
            PG8_LDA(At, 1, 1); PG8_STAGE(PG8_SB(1, 0), b3, voffB); PG8_STAGE(PG8_SB(1, 1), b3 + hstepB, voffB); PG8_STAGE(PG8_SA(1, 0), a3, voffA);
            PG8_WAIT_V(8); PG8_WAIT_L(0); PG8_BAR; PG8_MMA(1, 0, At, B0); PG8_MMA(1, 1, At, B1); PG8_BAR; PG8_SCHED;
        }
        if (wr == 0) PG8_BAR;
        { const int lane_ = fresh_lane();
          E(acc, cur, wr, wc, lane_ & 15, lane_ >> 4, scr, wid, lane_); }
        if (!has_next) break;
#pragma unroll
        for (int a = 0; a < 2; ++a)
#pragma unroll
            for (int b = 0; b < 2; ++b)
#pragma unroll
                for (int m = 0; m < 4; ++m)
#pragma unroll
                    for (int n = 0; n < 2; ++n) acc[a][b][m][n] = (f32x4){0.f, 0.f, 0.f, 0.f};
        cur = nxt; cA = nA; cB = nB; ++ui;
        if (wr == 1) PG8_BAR;
    }
    PG8_WAIT_V(0);
    PG8_BAR;
#undef PG8_SA
#undef PG8_SB
#undef PG8_STAGE
#undef PG8_LDA
#undef PG8_LDB
#undef PG8_MMA
#undef PG8_WAIT_V
#undef PG8_WAIT_L
#undef PG8_BAR
#undef PG8_SCHED
}
}

typedef f32x4 AccT[2][2][4][2];
__device__ __forceinline__ void st8(bf16_t* p, const f32x4& v0, const f32x4& v1) {
    u32x4 w; w.x = cvt_pk_bf16(v0[0], v0[1]); w.y = cvt_pk_bf16(v0[2], v0[3]); w.z = cvt_pk_bf16(v1[0], v1[1]); w.w = cvt_pk_bf16(v1[2], v1[3]);
    *(u32x4*)p = w;
}
struct EpiInProj {
    unsigned char* ws; unsigned char* dop; const float* qgain; const float* kgain; const float* bmerge; const f32x2* tab;
    __device__ __forceinline__ void operator()(AccT& acc, const pg8::Unit& u, int wr, int wc, int fr, int fq, LAS unsigned char* scr, int wid, int lane) const {
        const int seg = u.pn >> 2, ct = u.pn & 3;
        const size_t obase = seg == 0 ? WS_QS : seg == 1 ? WS_KS : seg == 2 ? WS_VS : seg == 3 ? WS_GS : seg == 5 ? WS_RK : seg == 7 ? WS_GR : seg == 8 ? WS_MA : WS_MB;
        bf16_t* O = (bf16_t*)(ws + obase);
        const int rt0 = wr * 64 + fr;
        const int cw = wc * 32 + 8 * fq;
        LAS float* P = (LAS float*)scr;
        f32x4 c0[2], c1[2];
        c0[0] = c0[1] = c1[0] = c1[1] = (f32x4){0.f, 0.f, 0.f, 0.f};
        if (seg <= 1) {
#pragma unroll
            for (int ai = 0; ai < 2; ++ai)
#pragma unroll
                for (int m = 0; m < 4; ++m)
#pragma unroll
                    for (int bj = 0; bj < 2; ++bj) {
                        const f32x4 a = acc[ai][bj][m][0], b = acc[ai][bj][m][1];
                        float s = (a[0] * a[0] + a[1] * a[1]) + (a[2] * a[2] + a[3] * a[3]) + (b[0] * b[0] + b[1] * b[1]) + (b[2] * b[2] + b[3] * b[3]);
                        s = sum_fq(s);
                        if (fq == 0) P[(ai * 128 + rt0 + m * 16) * 8 + bj * 4 + wc] = s;
                    }
            LDS_WAIT(); __builtin_amdgcn_s_barrier(); asm volatile("" ::: "memory");
            const float* gp = (seg == 0 ? qgain : kgain) + cw;
            c0[0] = c0[1] = *(const f32x4*)gp; c1[0] = c1[1] = *(const f32x4*)(gp + 4);
        } else if (seg >= 8) {
            const float* bp = bmerge + (seg - 8) * 1024 + ct * 256 + cw;
            c0[0] = *(const f32x4*)bp; c1[0] = *(const f32x4*)(bp + 4); c0[1] = *(const f32x4*)(bp + 128); c1[1] = *(const f32x4*)(bp + 132);
        }
#pragma unroll
        for (int ai = 0; ai < 2; ++ai)
#pragma unroll
            for (int m = 0; m < 4; ++m) {
                int zz = 0; asm volatile("" : "+v"(zz) :: "memory");
                const int rt = ai * 128 + rt0 + m * 16 + zz;
                f32x4 v[2][2];
#pragma unroll
                for (int bj = 0; bj < 2; ++bj) { v[bj][0] = acc[ai][bj][m][0]; v[bj][1] = acc[ai][bj][m][1]; }
                if (seg <= 1) {
                    const float sc = (seg == 0) ? QSCALE : 1.0f;
#pragma unroll
                    for (int bj = 0; bj < 2; ++bj) {
                        const f32x4 p = *(const LAS f32x4*)(P + rt * 8 + bj * 4);
                        const float rs = sc / sqrtf(((p[0] + p[1]) + (p[2] + p[3])) * (1.0f / 128.0f) + EPS);
                        v[bj][0] = v[bj][0] * c0[bj] * rs; v[bj][1] = v[bj][1] * c1[bj] * rs;
                    }
                } else if (seg == 3 || seg == 7) {
#pragma unroll
                    for (int bj = 0; bj < 2; ++bj)
#pragma unroll
                        for (int j = 0; j < 4; ++j) { v[bj][0][j] = v[bj][0][j] * fast_sigmoid(v[bj][0][j]); v[bj][1][j] = v[bj][1][j] * fast_sigmoid(v[bj][1][j]); }
                } else if (seg >= 8) {
#pragma unroll
                    for (int bj = 0; bj < 2; ++bj)
#pragma unroll
                        for (int j = 0; j < 4; ++j) { v[bj][0][j] = fast_sigmoid(v[bj][0][j] + c0[bj][j]); v[bj][1][j] = fast_sigmoid(v[bj][1][j] + c1[bj][j]); }
                } else if (seg == 4 || seg == 5) {
                    const float sc = (seg == 5) ? 0.0625f : 1.0f;
                    const int pos = (u.pm * 256 + rt) & (SEQ - 1);
                    const f32x4* tp = (const f32x4*)(tab + (size_t)pos * 128 + cw);
#pragma unroll
                    for (int n = 0; n < 2; ++n) {
                        const f32x4 t0 = tp[2 * n], t1 = tp[2 * n + 1];
                        const float cs[4] = {t0[0], t0[2], t1[0], t1[2]}, sn[4] = {t0[1], t0[3], t1[1], t1[3]};
#pragma unroll
                        for (int j = 0; j < 4; ++j) {
                            const float x1 = v[0][n][j], x2 = v[1][n][j];
                            v[0][n][j] = (x1 * cs[j] - x2 * sn[j]) * sc; v[1][n][j] = (x1 * sn[j] + x2 * cs[j]) * sc;
                        }
                    }
                }
                const int prow = u.pm * 256 + rt, pos = prow & (SEQ - 1), bl = prow >> 13, idx = pos & 255;
                const size_t ru = (size_t)((bl * RH + ct) * 32 + (pos >> 8));
                if (seg == 4) {
                    const float dq = __builtin_amdgcn_exp2f(log2gamma(ct) * (float)(idx + 1));
                    bf16_t* rowp = (bf16_t*)(ws + WS_A2) + (ru * 256 + idx) * 512 + 256 + cw;
                    st8(rowp, v[0][0] * dq, v[0][1] * dq); st8(rowp + 128, v[1][0] * dq, v[1][1] * dq);
                } else if (seg == 6) {
                    bf16_t* cp = (bf16_t*)(ws + WS_B2) + (ru * 256 + cw) * 512 + idx;
#pragma unroll
                    for (int bj = 0; bj < 2; ++bj)
#pragma unroll
                        for (int n = 0; n < 2; ++n)
#pragma unroll
                            for (int j = 0; j < 4; j += 2) { const unsigned w2 = cvt_pk_bf16(v[bj][n][j], v[bj][n][j + 1]);
                                cp[(size_t)(bj * 128 + 4 * n + j) * 512] = (bf16_t)(w2 & 0xffffu); cp[(size_t)(bj * 128 + 4 * n + j + 1) * 512] = (bf16_t)(w2 >> 16); }
                } else {
                    const float du = (seg == 5) ? __builtin_amdgcn_exp2f(-log2gamma(ct) * (float)(idx + 1)) : 1.0f;
                    bf16_t* rowp = O + (size_t)prow * 1024 + ct * 256 + cw;
                    st8(rowp, v[0][0] * du, v[0][1] * du); st8(rowp + 128, v[1][0] * du, v[1][1] * du);
                    if (seg == 5) {
                        const float dk = __builtin_amdgcn_exp2f(log2gamma(ct) * (float)(255 - idx));
                        bf16_t* cp = (bf16_t*)(dop + DO_KT) + (ru * 256 + cw) * 256 + idx;
#pragma unroll
                        for (int bj = 0; bj < 2; ++bj)
#pragma unroll
                            for (int n = 0; n < 2; ++n)
#pragma unroll
                                for (int j = 0; j < 4; j += 2) { const unsigned w2 = cvt_pk_bf16(v[bj][n][j] * dk, v[bj][n][j + 1] * dk);
                                    cp[(size_t)(bj * 128 + 4 * n + j) * 256] = (bf16_t)(w2 & 0xffffu); cp[(size_t)(bj * 128 + 4 * n + j + 1) * 256] = (bf16_t)(w2 >> 16); }
                    }
                }
            }
    }
};
template <bool ADD> struct EpiGate {
    const bf16_t* gate; const bf16_t* prev; bf16_t* out;
    __device__ __forceinline__ void operator()(AccT& acc, const pg8::Unit& u, int wr, int wc, int fr, int fq, LAS unsigned char* scr, int wid, int lane) const {
#pragma unroll
        for (int ai = 0; ai < 2; ++ai)
#pragma unroll
            for (int m = 0; m < 4; ++m) {
                const size_t off = (size_t)(u.pm * 256 + ai * 128 + wr * 64 + m * 16 + fr) * 1024 + u.pn * 256 + wc * 32 + 8 * fq;
#pragma unroll
                for (int bj = 0; bj < 2; ++bj) {
                    const u32x4 g = *(const u32x4*)(gate + off + bj * 128);
                    f32x4 v0 = acc[ai][bj][m][0], v1 = acc[ai][bj][m][1];
                    v0[0] *= bf_lo(g.x); v0[1] *= bf_hi(g.x); v0[2] *= bf_lo(g.y); v0[3] *= bf_hi(g.y);
                    v1[0] *= bf_lo(g.z); v1[1] *= bf_hi(g.z); v1[2] *= bf_lo(g.w); v1[3] *= bf_hi(g.w);
                    if (ADD) { const u32x4 p = *(const u32x4*)(prev + off + bj * 128);
                        v0[0] += bf_lo(p.x); v0[1] += bf_hi(p.x); v0[2] += bf_lo(p.y); v0[3] += bf_hi(p.y);
                        v1[0] += bf_lo(p.z); v1[1] += bf_hi(p.z); v1[2] += bf_lo(p.w); v1[3] += bf_hi(p.w); }
                    st8(out + off + bj * 128, v0, v1);
                }
            }
    }
};
struct EpiOut {
    const float* x; float* out;
    __device__ __forceinline__ void operator()(AccT& acc, const pg8::Unit& u, int wr, int wc, int fr, int fq, LAS unsigned char* scr, int wid, int lane) const {
#pragma unroll
        for (int ai = 0; ai < 2; ++ai)
#pragma unroll
            for (int m = 0; m < 4; ++m) {
                const size_t off = (size_t)(u.pm * 256 + ai * 128 + wr * 64 + m * 16 + fr) * 1024 + u.pn * 256 + wc * 32 + 8 * fq;
#pragma unroll
                for (int bj = 0; bj < 2; ++bj)
#pragma unroll
                    for (int n = 0; n < 2; ++n) { const f32x4 xv = *(const f32x4*)(x + off + bj * 128 + 4 * n); *(f32x4*)(out + off + bj * 128 + 4 * n) = xv + acc[ai][bj][m][n]; }
            }
    }
};

struct RetOrder {
    int mode, G, c; const char* A2; const char* B2; const char* KT; const char* RKp;
    __device__ bool next(int i, pg8::Unit& u) const { const int id = c + i * G; if (id >= RUNITS) return false; u.pm = id; u.pn = 0; return true; }
    __device__ __forceinline__ void ptrs(const pg8::Unit& u, const char*& a, const char*& b) const {
        const size_t t2 = (size_t)u.pm * (256 * 512 * 2);
        if (mode == 0) { a = B2 + t2; b = KT + (size_t)u.pm * (256 * 256 * 2); }
        else if (mode == 1) { const int bl = u.pm >> 7, h = (u.pm >> 5) & 3, N = u.pm & 31; a = A2 + t2 + 512; b = RKp + ((size_t)(bl * SEQ + N * 256) * 1024 + h * RD) * 2; }
        else { a = A2 + t2; b = B2 + t2; }
    }
};
struct EpiU {
    bf16_t* U;
    __device__ __forceinline__ void operator()(AccT& acc, const pg8::Unit& u, int wr, int wc, int fr, int fq, LAS unsigned char* scr, int wid, int lane) const {
#pragma unroll
        for (int ai = 0; ai < 2; ++ai)
#pragma unroll
            for (int m = 0; m < 4; ++m) {
                bf16_t* rowp = U + ((size_t)u.pm * 256 + ai * 128 + wr * 64 + m * 16 + fr) * 256 + wc * 32 + 8 * fq;
                st8(rowp, acc[ai][0][m][0], acc[ai][0][m][1]); st8(rowp + 128, acc[ai][1][m][0], acc[ai][1][m][1]);
            }
    }
};
struct EpiP {
    bf16_t* A2;
    __device__ __forceinline__ void operator()(AccT& acc, const pg8::Unit& u, int wr, int wc, int fr, int fq, LAS unsigned char* scr, int wid, int lane) const {
        const float l2g2 = 2.0f * log2gamma((u.pm >> 5) & 3);
#pragma unroll
        for (int ai = 0; ai < 2; ++ai)
#pragma unroll
            for (int m = 0; m < 4; ++m) {
                int zz = 0; asm volatile("" : "+v"(zz) :: "memory");
                const int t = ai * 128 + wr * 64 + m * 16 + fr + zz;
                bf16_t* rowp = A2 + ((size_t)u.pm * 256 + t) * 512 + wc * 32 + 8 * fq;
#pragma unroll
                for (int bj = 0; bj < 2; ++bj) {
                    const int crel = (2 * bj + (wc >> 1)) - (2 * ai + wr);
                    f32x4 v[2];
                    if (crel > 0) { v[0] = v[1] = (f32x4){0.f, 0.f, 0.f, 0.f}; }
                    else if (crel < 0) { v[0] = acc[ai][bj][m][0]; v[1] = acc[ai][bj][m][1]; }
                    else {
#pragma unroll
                        for (int n = 0; n < 2; ++n)
#pragma unroll
                            for (int j = 0; j < 4; ++j) {
                                const int s = bj * 128 + wc * 32 + 8 * fq + 4 * n + j;
                                const float dm = (s > t) ? __builtin_amdgcn_exp2f(l2g2 * (float)(s - t)) : 1.0f;
                                v[n][j] = acc[ai][bj][m][n][j] * dm;
                            }
                    }
                    st8(rowp + bj * 128, v[0], v[1]);
                }
            }
    }
};
struct EpiO {
    bf16_t* OB; const bf16_t* GR; const float* rgain;
    __device__ __forceinline__ void operator()(AccT& acc, const pg8::Unit& u, int wr, int wc, int fr, int fq, LAS unsigned char* scr, int wid, int lane) const {
        const int bl = u.pm >> 7, h = (u.pm >> 5) & 3, N = u.pm & 31;
        LAS float* P = (LAS float*)scr;
#pragma unroll
        for (int ai = 0; ai < 2; ++ai)
#pragma unroll
            for (int m = 0; m < 4; ++m) {
                float s = 0.f;
#pragma unroll
                for (int bj = 0; bj < 2; ++bj)
#pragma unroll
                    for (int n = 0; n < 2; ++n) { const f32x4 a = acc[ai][bj][m][n]; s += (a[0] * a[0] + a[1] * a[1]) + (a[2] * a[2] + a[3] * a[3]); }
                s = sum_fq(s);
                if (fq == 0) P[(ai * 128 + wr * 64 + m * 16 + fr) * 4 + wc] = s;
            }
        LDS_WAIT(); __builtin_amdgcn_s_barrier(); asm volatile("" ::: "memory");
        const float* gp = rgain + h * RD + wc * 32 + 8 * fq;
        f32x4 g[2][2];
#pragma unroll
        for (int bj = 0; bj < 2; ++bj) { g[bj][0] = *(const f32x4*)(gp + bj * 128); g[bj][1] = *(const f32x4*)(gp + bj * 128 + 4); }
#pragma unroll
        for (int ai = 0; ai < 2; ++ai)
#pragma unroll
            for (int m = 0; m < 4; ++m) {
                int zz = 0; asm volatile("" : "+v"(zz) :: "memory");
                const int t = ai * 128 + wr * 64 + m * 16 + fr + zz;
                const f32x4 p = *(const LAS f32x4*)(P + t * 4);
                const float rs = 1.0f / sqrtf(((p[0] + p[1]) + (p[2] + p[3])) * (1.0f / RD) + EPS);
                const size_t off = ((size_t)(bl * SEQ + N * 256 + t)) * 1024 + h * RD + wc * 32 + 8 * fq;
#pragma unroll
                for (int bj = 0; bj < 2; ++bj) {
                    const u32x4 gt = *(const u32x4*)(GR + off + bj * 128);
                    f32x4 v0 = acc[ai][bj][m][0] * g[bj][0] * rs, v1 = acc[ai][bj][m][1] * g[bj][1] * rs;
                    v0[0] *= bf_lo(gt.x); v0[1] *= bf_hi(gt.x); v0[2] *= bf_lo(gt.y); v0[3] *= bf_hi(gt.y);
                    v1[0] *= bf_lo(gt.z); v1[1] *= bf_hi(gt.z); v1[2] *= bf_lo(gt.w); v1[3] *= bf_hi(gt.w);
                    st8(OB + off + bj * 128, v0, v1);
                }
            }
    }
};
__device__ __forceinline__ void ret_scan(int gtid, int nthreads, const bf16_t* U, bf16_t* B2) {
    asm volatile("" : "+v"(gtid));
    for (int it = gtid; it < 2 * RH * 256 * 64; it += nthreads) {
        const int dk4 = it & 63, dv = (it >> 6) & 255, bh = it >> 14;
        const float g256 = __builtin_amdgcn_exp2f(256.0f * log2gamma(bh & 3));
        const bf16_t* up = U + ((size_t)(bh * 32) * 256 + dv) * 256 + 4 * dk4;
        bf16_t* sp = B2 + ((size_t)(bh * 32) * 256 + dv) * 512 + 256 + 4 * dk4;
        float s0 = 0.f, s1 = 0.f, s2 = 0.f, s3 = 0.f;
#pragma unroll 8
        for (int N = 0; N < 32; ++N) {
            u32x2 o; o.x = cvt_pk_bf16(s0, s1); o.y = cvt_pk_bf16(s2, s3);
            *(u32x2*)(sp + (size_t)N * 256 * 512) = o;
            const u32x2 uv = *(const u32x2*)(up + (size_t)N * 256 * 256);
            s0 = g256 * s0 + bf_lo(uv.x); s1 = g256 * s1 + bf_hi(uv.x); s2 = g256 * s2 + bf_lo(uv.y); s3 = g256 * s3 + bf_hi(uv.y);
        }
    }
}

#define XB_TMO      128
#define XB_XCNT(j)  (256  + 64 * (j))
#define XB_XSUB(j)  (1280 + 64 * (j))
#define XB_XGEN(j)  (2304 + 64 * (j))
#define XB_TOP      3328
#define XB_TOPGEN   3392
#define XCD_BAR_WORDS 3456
#define XB_SPIN_CAP (1u << 18)
__device__ __forceinline__ unsigned xb_ld(unsigned* p)              { return __hip_atomic_load(p, __ATOMIC_RELAXED, __HIP_MEMORY_SCOPE_AGENT); }
__device__ __forceinline__ unsigned xb_add(unsigned* p, unsigned v) { return __hip_atomic_fetch_add(p, v, __ATOMIC_RELAXED, __HIP_MEMORY_SCOPE_AGENT); }
__device__ __forceinline__ unsigned xb_xcc_id() { return (unsigned)__builtin_amdgcn_s_getreg((3 << 11) | 20) & 0xFu; }
#define XB_SPIN(cond, bar) do { unsigned _sp = 0; while (cond) { __builtin_amdgcn_s_sleep(1); \
    if ((++_sp & 255u) == 0u) { if (xb_ld(&(bar)[XB_TMO])) break; if (_sp > XB_SPIN_CAP) { atomicAdd(&(bar)[XB_TMO], 1u); break; } } } } while (0)
struct XcdBarrier { unsigned* bar; unsigned x; volatile LAS unsigned* st; };
__device__ __forceinline__ XcdBarrier xcd_barrier_post(unsigned* bar, volatile LAS unsigned* st) {
    XcdBarrier b; b.bar = bar; b.x = xb_xcc_id(); b.st = st;
    if (threadIdx.x == 0) (void)xb_add(&bar[XB_XCNT(b.x)], 1u);
    return b;
}
__device__ __forceinline__ void xcd_barrier_complete(unsigned* bar, unsigned x, unsigned& nloc, unsigned& nx) {
    const unsigned G = gridDim.x * gridDim.y * gridDim.z;
    unsigned sum, cnt, mine, sp = 0u;
    for (;;) {
        sum = 0u; cnt = 0u; mine = 0u;
#pragma unroll
        for (unsigned j = 0; j < 16; ++j) { const unsigned c = xb_ld(&bar[XB_XCNT(j)]); sum += c; cnt += (c > 0u) ? 1u : 0u; mine = (j == x) ? c : mine; }
        if (sum == G) break;
        __builtin_amdgcn_s_sleep(1);
        if ((++sp & 255u) == 0u) { if (xb_ld(&bar[XB_TMO])) break; if (sp > XB_SPIN_CAP) { atomicAdd(&bar[XB_TMO], 1u); break; } }
    }
    nloc = mine > 0u ? mine : 1u; nx = cnt > 0u ? cnt : 1u;
}
__device__ __forceinline__ void xcd_barrier(const XcdBarrier& b) {
    asm volatile("s_waitcnt vmcnt(0)" ::: "memory");
    __syncthreads();
    if (threadIdx.x == 0) {
        unsigned* bar = b.bar;
        __builtin_amdgcn_s_waitcnt(0);
        unsigned nloc = b.st[0], nx = b.st[1];
        unsigned bx_ = b.x; asm volatile("" : "+s"(bx_));
        if (nloc == 0u) { xcd_barrier_complete(bar, bx_, nloc, nx); b.st[0] = nloc; b.st[1] = nx; }
        const unsigned old = xb_add(&bar[XB_XSUB(b.x)], 1u);
        const unsigned gen = old / nloc;
        if (old + 1u == (gen + 1u) * nloc) {
            __builtin_amdgcn_fence(__ATOMIC_RELEASE, "agent");
            asm volatile("s_waitcnt vmcnt(0)" ::: "memory");
            const unsigned og = xb_add(&bar[XB_TOP], 1u);
            const unsigned tg = og / nx;
            if (og + 1u == (tg + 1u) * nx) xb_add(&bar[XB_TOPGEN], 1u);
            else XB_SPIN(xb_ld(&bar[XB_TOPGEN]) == tg, bar);
            __builtin_amdgcn_fence(__ATOMIC_ACQUIRE, "agent");
            xb_add(&bar[XB_XGEN(b.x)], 1u);
            asm volatile("s_waitcnt vmcnt(0)" ::: "memory");
        } else {
            XB_SPIN(xb_ld(&bar[XB_XGEN(b.x)]) == gen, bar);
            __builtin_amdgcn_fence(__ATOMIC_ACQUIRE, "agent");
            asm volatile("s_waitcnt vmcnt(0)" ::: "memory");
        }
    }
    __syncthreads();
}

__device__ __forceinline__ void p0_transpose_item(const float* W, int K, int N, bf16_t* WT, LAS float* scr, int item, int lane) {
    const int nblk = N / 32, kb = item / nblk, nb = item % nblk, k0 = 64 * kb, n0 = 32 * nb;
#pragma unroll 8
    for (int i = 0; i < 32; ++i) { const int kk = 2 * i + (lane >> 5); scr[kk * 33 + (lane & 31)] = W[(size_t)(k0 + kk) * N + n0 + (lane & 31)]; }
    LDS_WAIT(); asm volatile("" ::: "memory");
    const int c = lane & 7;
#pragma unroll
    for (int j = 0; j < 4; ++j) { const int n = (lane >> 3) + 8 * j; const LAS float* s = scr + (8 * c) * 33 + n;
        u32x4 o; o.x = cvt_pk_bf16(s[0 * 33], s[1 * 33]); o.y = cvt_pk_bf16(s[2 * 33], s[3 * 33]); o.z = cvt_pk_bf16(s[4 * 33], s[5 * 33]); o.w = cvt_pk_bf16(s[6 * 33], s[7 * 33]);
        *(u32x4*)(WT + (size_t)(n0 + n) * K + k0 + 8 * c) = o; }
    LDS_WAIT(); asm volatile("" ::: "memory");
}
__device__ __forceinline__ void p0_prologue(LAS unsigned char* lds, int vcu, int G, int wave, int lane, const float* x, const float* ngain, const float* w_in, const float* w_sb, const float* w_ret, const float* w_out,
                                            bf16_t* WinT, bf16_t* WsbT, bf16_t* WretT, bf16_t* WoutT, bf16_t* H, f32x2* tab) {
    asm volatile("" : "+v"(lane));
    LAS float* scr = (LAS float*)(lds + wave * 16384);
    const int gw = vcu * NWAVES + wave, NGW = G * NWAVES;
    constexpr int I_IN = (D / 64) * (INC / 32), I_SQ = (D / 64) * (D / 32);
    for (int it = gw; it < I_IN + 3 * I_SQ; it += NGW) {
        int r = it;
        if (r < I_IN) { p0_transpose_item(w_in, D, INC, WinT, scr, r, lane); continue; } r -= I_IN;
        if (r < I_SQ) { p0_transpose_item(w_sb, D, D, WsbT, scr, r, lane); continue; } r -= I_SQ;
        if (r < I_SQ) { p0_transpose_item(w_ret, D, D, WretT, scr, r, lane); continue; } r -= I_SQ;
        p0_transpose_item(w_out, D, D, WoutT, scr, r, lane);
    }
    f32x4 g[4];
#pragma unroll
    for (int j = 0; j < 4; ++j) g[j] = ((const f32x4*)ngain)[64 * j + lane];
    for (int m = gw; m < NTOK; m += NGW) {
        const f32x4* xr = (const f32x4*)(x + (size_t)m * D) + lane;
        f32x4 v[4]; float s = 0.f;
#pragma unroll
        for (int j = 0; j < 4; ++j) { v[j] = xr[64 * j]; s += (v[j][0] * v[j][0] + v[j][1] * v[j][1]) + (v[j][2] * v[j][2] + v[j][3] * v[j][3]); }
        const float rs = 1.0f / sqrtf(wave_sum(s) * (1.0f / D) + EPS);
        u32x2* o = (u32x2*)(H + (size_t)m * D) + lane;
#pragma unroll
        for (int j = 0; j < 4; ++j) { const f32x4 y = v[j] * rs * g[j]; u32x2 w; w.x = cvt_pk_bf16(y[0], y[1]); w.y = cvt_pk_bf16(y[2], y[3]); o[64 * j] = w; }
    }
    for (int e = (vcu * NWAVES + wave) * 64 + lane; e < SEQ * 128; e += G * NWAVES * 64) {
        const int pos = e >> 7, i = e & 127;
        const float angf = (float)pos * INVF[i];
        const double a = (double)angf;
        const double k = __builtin_rint(a * 0.63661977236758134308);
        double r = __builtin_fma(-k, 1.57079632679489655800, a); r = __builtin_fma(-k, 6.12323399573676603587e-17, r);
        const double r2 = r * r;
        double sp = 1.0 / 6227020800.0; sp = sp * r2 - 1.0 / 39916800.0; sp = sp * r2 + 1.0 / 362880.0; sp = sp * r2 - 1.0 / 5040.0; sp = sp * r2 + 1.0 / 120.0; sp = sp * r2 - 1.0 / 6.0; sp = sp * r2 + 1.0;
        const double sn = r * sp;
        double cp = -1.0 / 87178291200.0; cp = cp * r2 + 1.0 / 479001600.0; cp = cp * r2 - 1.0 / 3628800.0; cp = cp * r2 + 1.0 / 40320.0; cp = cp * r2 - 1.0 / 720.0; cp = cp * r2 + 1.0 / 24.0; cp = cp * r2 - 0.5; cp = cp * r2 + 1.0;
        const int q = (int)((long long)k & 3);
        const double c_ = (q == 0) ? cp : (q == 1) ? -sn : (q == 2) ? -cp : sn;
        const double s_ = (q == 0) ? sn : (q == 1) ? cp : (q == 2) ? -sn : -cp;
        tab[e] = (f32x2){(float)c_, (float)s_};
    }
}

namespace sba {
typedef float f32x16 __attribute__((ext_vector_type(16)));
typedef short v4i16_t __attribute__((ext_vector_type(4)));
constexpr int LDS_K = 0, LDS_V = 32768, LDS_O = 65536;
__device__ __forceinline__ int crow(int r, int hi) { return (r & 3) + 8 * (r >> 2) + 4 * hi; }
__device__ __forceinline__ unsigned offK(int row, int ch) { return (unsigned)(ch * 1024 + ((row ^ (ch & 7)) << 4)); }
__device__ __forceinline__ unsigned offV(int row, int ch) { return (unsigned)(256 * row + 16 * (ch ^ (((row & 3) << 2) | ((row >> 2) & 3)))); }

__device__ __forceinline__ void attn_unit(LAS unsigned char* lds, volatile LAS unsigned* flags, const int w, int bl, int h, int qb, bf16_t* QS, const bf16_t* KS, const bf16_t* VS, const bf16_t* GS) {
    const int lane = fresh_lane(), tid = w * 64 + lane, r = lane & 31, hh = lane >> 5;
    const size_t tok0 = (size_t)bl * SEQ;
    const int qpos = 256 * qb + 32 * w + r;
    const int jtop = 4 * qb + 3, jmine = 4 * qb + (w >> 1);
    bf16x8 qf[8];
    { const bf16_t* qp = QS + (tok0 + qpos) * 1024 + h * SBD + 8 * hh;
#pragma unroll
      for (int ks = 0; ks < 8; ++ks) qf[ks] = *(const bf16x8*)(qp + 16 * ks); }
    const int srow = tid >> 4, sch = tid & 15;
    const bf16_t* kg = KS + (tok0 + srow) * 1024 + h * SBD + sch * 8;
    const bf16_t* vg = VS + (tok0 + srow) * 1024 + h * SBD + sch * 8;
    const unsigned kst0 = offK(srow, sch), kst1 = offK(srow + 32, sch), vst0 = offV(srow, sch), vst1 = offV(srow + 32, sch);
    unsigned kb4[4];
#pragma unroll
    for (int i = 0; i < 4; ++i) kb4[i] = (unsigned)(hh * 1024 + ((r ^ (2 * i + hh)) << 4));
    unsigned vb8[4][2];
    { const int blk = (lane >> 4) & 1, q4 = (lane & 15) >> 2, p = lane & 3;
#pragma unroll
      for (int db = 0; db < 4; ++db)
#pragma unroll
          for (int t = 0; t < 2; ++t) vb8[db][t] = offV(8 * t + 4 * hh + q4, 4 * db + 2 * blk + (p >> 1)) + 8 * (p & 1); }
    f32x16 o[4];
#pragma unroll
    for (int db = 0; db < 4; ++db)
#pragma unroll
        for (int i = 0; i < 16; ++i) o[db][i] = 0.f;
    float Rp = 1.0f; bool wdone = false;
    u32x4 kr0, kr1, vr0, vr1;
    { const size_t go = (size_t)(64 * jtop) * 1024;
      kr0 = *(const u32x4*)(kg + go); kr1 = *(const u32x4*)(kg + go + 32 * 1024); vr0 = *(const u32x4*)(vg + go); vr1 = *(const u32x4*)(vg + go + 32 * 1024); }
    int buf = 0, it = 0;
    for (int jt = jtop; ; --jt, buf ^= 1, ++it) {
        LAS unsigned char* Kb = lds + LDS_K + buf * 16384; LAS unsigned char* Vb = lds + LDS_V + buf * 16384;
        *(LAS u32x4*)(Kb + kst0) = kr0; *(LAS u32x4*)(Kb + kst1) = kr1; *(LAS u32x4*)(Vb + vst0) = vr0; *(LAS u32x4*)(Vb + vst1) = vr1;
        if (jt > 0) { const size_t go = (size_t)(64 * (jt - 1)) * 1024;
            kr0 = *(const u32x4*)(kg + go); kr1 = *(const u32x4*)(kg + go + 32 * 1024); vr0 = *(const u32x4*)(vg + go); vr1 = *(const u32x4*)(vg + go + 32 * 1024); }
        if (lane == 0) flags[(it & 1) * 8 + w] = wdone ? 1u : 0u;
        LDS_WAIT(); __builtin_amdgcn_s_barrier(); asm volatile("" ::: "memory");
        { unsigned all = 1u;
#pragma unroll
          for (int i = 0; i < 8; ++i) all &= flags[(it & 1) * 8 + i];
          if (__builtin_amdgcn_readfirstlane(all)) break; }
        if (jt <= jmine && !wdone) {
            f32x16 p0, p1;
#pragma unroll
            for (int i = 0; i < 16; ++i) { p0[i] = 0.f; p1[i] = 0.f; }
#pragma unroll
            for (int ks = 0; ks < 8; ++ks) {
                const bf16x8 k0 = *(const LAS bf16x8*)(Kb + kb4[ks & 3] + 2048 * ks);
                const bf16x8 k1 = *(const LAS bf16x8*)(Kb + kb4[ks & 3] + 2048 * ks + 512);
                p0 = __builtin_amdgcn_mfma_f32_32x32x16_bf16(k0, qf[ks], p0, 0, 0, 0);
                p1 = __builtin_amdgcn_mfma_f32_32x32x16_bf16(k1, qf[ks], p1, 0, 0, 0);
            }
            if (jt >= 4 * qb) {
                const int kbase = 64 * jt + 4 * hh;
#pragma unroll
                for (int i = 0; i < 16; ++i) { const int key = kbase + (i & 3) + 8 * (i >> 2); if (key >= qpos) p0[i] = -INFINITY; if (key + 32 >= qpos) p1[i] = -INFINITY; }
            }
            float wgt[2][16]; float T[2][4], Pz[2][4];
#pragma unroll
            for (int kb = 0; kb < 2; ++kb) {
#pragma unroll
                for (int i = 0; i < 16; ++i) { const float y = kb ? p1[i] : p0[i]; const float kp = __builtin_amdgcn_rcpf(1.0f + __builtin_amdgcn_exp2f(y)); wgt[kb][i] = kp; }
            }
            float c1[2][4], c2[2][4];
#pragma unroll
            for (int kb = 0; kb < 2; ++kb)
#pragma unroll
                for (int g = 0; g < 4; ++g) {
                    c1[kb][g] = wgt[kb][4 * g + 3] * wgt[kb][4 * g + 2]; c2[kb][g] = c1[kb][g] * wgt[kb][4 * g + 1];
                    const float M = c2[kb][g] * wgt[kb][4 * g];
                    const auto rr = __builtin_amdgcn_permlane32_swap(__float_as_uint(M), __float_as_uint(M), false, false);
                    const float mlo = __uint_as_float(rr[0]), mhi = __uint_as_float(rr[1]);
                    T[kb][g] = mlo * mhi; Pz[kb][g] = hh ? 1.0f : mhi;
                }
            float X = Rp;
#pragma unroll
            for (int kb = 1; kb >= 0; --kb)
#pragma unroll
                for (int g = 3; g >= 0; --g) {
                    const float off = X * Pz[kb][g]; X *= T[kb][g];
                    const float k3 = wgt[kb][4 * g + 3], k2 = wgt[kb][4 * g + 2], k1 = wgt[kb][4 * g + 1], k0 = wgt[kb][4 * g];
                    wgt[kb][4 * g + 3] = (1.0f - k3) * off;
                    wgt[kb][4 * g + 2] = (1.0f - k2) * (off * k3);
                    wgt[kb][4 * g + 1] = (1.0f - k1) * (off * c1[kb][g]);
                    wgt[kb][4 * g]     = (1.0f - k0) * (off * c2[kb][g]);
                }
            Rp = X;
            u32x4 pa[4];
#pragma unroll
            for (int s = 0; s < 4; ++s) { const int kb = s >> 1, b8 = 8 * (s & 1);
                pa[s].x = cvt_pk_bf16(wgt[kb][b8], wgt[kb][b8 + 1]); pa[s].y = cvt_pk_bf16(wgt[kb][b8 + 2], wgt[kb][b8 + 3]);
                pa[s].z = cvt_pk_bf16(wgt[kb][b8 + 4], wgt[kb][b8 + 5]); pa[s].w = cvt_pk_bf16(wgt[kb][b8 + 6], wgt[kb][b8 + 7]); }
#pragma unroll
            for (int s = 0; s < 4; ++s)
#pragma unroll
                for (int db = 0; db < 4; ++db) {
                    const v4i16_t lo = __builtin_amdgcn_ds_read_tr16_b64_v4i16((LAS v4i16_t*)(Vb + vb8[db][0] + 4096 * s));
                    const v4i16_t hi = __builtin_amdgcn_ds_read_tr16_b64_v4i16((LAS v4i16_t*)(Vb + vb8[db][1] + 4096 * s));
                    const bf16x8 vf = (bf16x8){lo[0], lo[1], lo[2], lo[3], hi[0], hi[1], hi[2], hi[3]};
                    o[db] = __builtin_amdgcn_mfma_f32_32x32x16_bf16(__builtin_bit_cast(bf16x8, pa[s]), vf, o[db], 0, 0, 0);
                }
            wdone = __all(Rp < 1.17549435e-38f);
        }
        if (jt == 0) break;
    }
    LAS bf16_t* stg = (LAS bf16_t*)(lds + LDS_O + w * 8192);
#pragma unroll
    for (int db = 0; db < 4; ++db)
#pragma unroll
        for (int i = 0; i < 16; ++i) stg[crow(i, hh) * 128 + 32 * db + r] = (bf16_t)(cvt_pk_bf16(o[db][i], 0.f) & 0xffffu);
    LDS_WAIT(); asm volatile("" ::: "memory");
#pragma unroll
    for (int i = 0; i < 8; ++i) {
        const int row = 4 * i + (lane >> 4), ch = lane & 15;
        const u32x4 ov = *(const LAS u32x4*)(stg + row * 128 + ch * 8);
        const size_t go = (tok0 + 256 * qb + 32 * w + row) * 1024 + h * SBD + ch * 8;
        const u32x4 gv = *(const u32x4*)(GS + go);
        u32x4 res;
        res.x = cvt_pk_bf16(bf_lo(ov.x) * bf_lo(gv.x), bf_hi(ov.x) * bf_hi(gv.x)); res.y = cvt_pk_bf16(bf_lo(ov.y) * bf_lo(gv.y), bf_hi(ov.y) * bf_hi(gv.y));
        res.z = cvt_pk_bf16(bf_lo(ov.z) * bf_lo(gv.z), bf_hi(ov.z) * bf_hi(gv.z)); res.w = cvt_pk_bf16(bf_lo(ov.w) * bf_lo(gv.w), bf_hi(ov.w) * bf_hi(gv.w));
        *(u32x4*)(QS + go) = res;
    }
    LDS_WAIT(); __builtin_amdgcn_s_barrier(); asm volatile("" ::: "memory");
}
__device__ __forceinline__ void attn_phase(LAS unsigned char* lds, volatile LAS unsigned* flags, const int w, int G, int bx, bf16_t* QS, const bf16_t* KS, const bf16_t* VS, const bf16_t* GS) {
    for (int u = bx; u < 2 * SBH * 32; u += G) { const int qb = u & 31, bh = u >> 5; attn_unit(lds, flags, w, bh >> 3, bh & 7, qb, QS, KS, VS, GS); }
}
}

__device__ __forceinline__ void naive_attention(int gw, int NGW, int lane, bf16_t* QS, const bf16_t* KS, const bf16_t* VS, const bf16_t* GS) {
    asm volatile("" : "+v"(lane));
    for (int task = gw; task < 2 * SBH * SEQ; task += NGW) {
        const int t = task & (SEQ - 1), bh = task >> 13, h = bh & 7, bl = bh >> 3;
        const size_t rowq = (size_t)(bl * SEQ + t) * 1024 + h * SBD + 2 * lane;
        const unsigned qw = *(const unsigned*)(QS + rowq);
        const float q0 = bf_lo(qw), q1 = bf_hi(qw);
        float a0 = 0.f, a1 = 0.f, run = 0.f;
        const bf16_t* kb = KS + (size_t)(bl * SEQ) * 1024 + h * SBD + 2 * lane;
        const bf16_t* vb = VS + (size_t)(bl * SEQ) * 1024 + h * SBD + 2 * lane;
        for (int s = t - 1; s >= 0; --s) {
            const unsigned kw = *(const unsigned*)(kb + (size_t)s * 1024);
            const unsigned vw = *(const unsigned*)(vb + (size_t)s * 1024);
            const float y = wave_sum(q0 * bf_lo(kw) + q1 * bf_hi(kw));
            const float z = y * LN2F;
            const float sp = fmaxf(z, 0.f) + log1pf(expf(-fabsf(z)));
            const float w = expf((z - sp) + run);
            run -= sp;
            a0 += w * bf_lo(vw); a1 += w * bf_hi(vw);
            if (run < -110.f) break;
        }
        const unsigned gwd = *(const unsigned*)(GS + rowq);
        *(unsigned*)(QS + rowq) = cvt_pk_bf16(a0 * bf_lo(gwd), a1 * bf_hi(gwd));
    }
}
__device__ __forceinline__ void naive_retention(int gw, int NGW, int lane, bf16_t* RQ, const bf16_t* RK, const bf16_t* RV, const bf16_t* GR, const float* rgain) {
    asm volatile("" : "+v"(lane));
    for (int task = gw; task < 2 * RH * SEQ; task += NGW) {
        const int t = task & (SEQ - 1), bh = task >> 13, h = bh & 3, bl = bh >> 2;
        const size_t rowq = (size_t)(bl * SEQ + t) * 1024 + h * RD + 4 * lane;
        const u32x2 qw = *(const u32x2*)(RQ + rowq);
        const float q0 = bf_lo(qw.x), q1 = bf_hi(qw.x), q2 = bf_lo(qw.y), q3 = bf_hi(qw.y);
        float a0 = 0.f, a1 = 0.f, a2 = 0.f, a3 = 0.f;
        const bf16_t* kb = RK + (size_t)(bl * SEQ) * 1024 + h * RD + 4 * lane;
        const bf16_t* vb = RV + (size_t)(bl * SEQ) * 1024 + h * RD + 4 * lane;
        const float l2g = log2gamma(h);
        const int send = (t | 63) + 1;
#pragma unroll 4
        for (int s = 0; s < send; ++s) {
            const u32x2 kw = *(const u32x2*)(kb + (size_t)s * 1024);
            const u32x2 vw = *(const u32x2*)(vb + (size_t)s * 1024);
            const float d = wave_sum((q0 * bf_lo(kw.x) + q1 * bf_hi(kw.x)) + (q2 * bf_lo(kw.y) + q3 * bf_hi(kw.y)));
            const int dist = t > s ? t - s : s - t;
            const float w = d * __builtin_amdgcn_exp2f(l2g * (float)dist);
            a0 += w * bf_lo(vw.x); a1 += w * bf_hi(vw.x); a2 += w * bf_lo(vw.y); a3 += w * bf_hi(vw.y);
        }
        const float ss = wave_sum((a0 * a0 + a1 * a1) + (a2 * a2 + a3 * a3));
        const float rs = 1.0f / sqrtf(ss * (1.0f / RD) + EPS);
        const f32x4 g = *(const f32x4*)(rgain + h * RD + 4 * lane);
        const u32x2 gw2 = *(const u32x2*)(GR + rowq);
        u32x2 o; o.x = cvt_pk_bf16(a0 * rs * g[0] * bf_lo(gw2.x), a1 * rs * g[1] * bf_hi(gw2.x)); o.y = cvt_pk_bf16(a2 * rs * g[2] * bf_lo(gw2.y), a3 * rs * g[3] * bf_hi(gw2.y));
        *(u32x2*)(RQ + rowq) = o;
    }
}

__device__ __forceinline__ bool ph_in(int lo, int hi, int k) { asm volatile("" : "+s"(lo), "+s"(hi)); return lo <= k && k < hi; }
constexpr int NPHASE = 1 + 6 * NPASS;
struct Args { const float* in[10]; float* out; unsigned char* ws; int ph_lo, ph_hi; };
__device__ __forceinline__ unsigned char* lds_ptr(volatile LAS unsigned* tabl, int i) {
    const unsigned lo = __builtin_amdgcn_readfirstlane(tabl[2 * i]), hi = __builtin_amdgcn_readfirstlane(tabl[2 * i + 1]);
    return (unsigned char*)(((unsigned long long)hi << 32) | lo);
}
__global__ void __launch_bounds__(NWAVES * 64, 2) fwd(Args args) {
    extern __shared__ __attribute__((aligned(16))) unsigned char lds_raw[];
    LAS unsigned char* lds = (LAS unsigned char*)lds_raw;
    volatile LAS unsigned* MISC = (volatile LAS unsigned*)(lds + MISC_OFF);
    const int tid = threadIdx.x, lane = tid & 63, wave = __builtin_amdgcn_readfirstlane(tid >> 6);
    if (tid < 32) MISC[tid] = 0u;
    if (tid < 12) { const unsigned long long pv = (tid < 10) ? (unsigned long long)args.in[tid] : (tid == 10) ? (unsigned long long)args.out : (unsigned long long)args.ws;
        MISC[32 + 2 * tid] = (unsigned)pv; MISC[32 + 2 * tid + 1] = (unsigned)(pv >> 32); }
    __syncthreads();
    volatile LAS unsigned* PT = MISC + 32;
#define P_IN(i) ((const float*)lds_ptr(PT, (i)))
#define P_OUT() ((float*)lds_ptr(PT, 10))
#define P_WS() (lds_ptr(PT, 11))
    const int lo = args.ph_lo, hi = args.ph_hi;
    const bool use_bar = (hi - lo) > 1;
    XcdBarrier bar; bar.bar = (unsigned*)(args.ws + WS_CTL) + CW_BAR; bar.x = 0; bar.st = MISC + 8;
    if (use_bar) bar = xcd_barrier_post((unsigned*)(args.ws + WS_CTL) + CW_BAR, MISC + 8);
#define IN(k) ph_in(lo, hi, (k))
#define BOTH(k) (IN(k) && IN((k) + 1))
#define GRID_BAR() xcd_barrier(bar)
#define VCU() ((int)((gridDim.x % 8 == 0) ? (blockIdx.x % 8) * (gridDim.x / 8) + blockIdx.x / 8 : blockIdx.x))
    LAS unsigned char* scr = lds + SCR_OFF;

    if (IN(0)) {
        unsigned char* ws = P_WS();
        p0_prologue(lds, VCU(), gridDim.x, wave, fresh_lane(), P_IN(0), P_IN(1), P_IN(2), P_IN(7), P_IN(8), P_IN(9),
                    (bf16_t*)(ws + WS_WIN), (bf16_t*)(ws + WS_WSB), (bf16_t*)(ws + WS_WRET), (bf16_t*)(ws + WS_WOUT), (bf16_t*)(ws + WS_H), (f32x2*)(ws + WS_TAB));
        if (BOTH(0)) GRID_BAR();
    }

    _Pragma("unroll") for (int p = 0; p < NPASS; ++p) {
        const int pb = 1 + 6 * p;
        if (IN(pb + 0)) {
            unsigned char* ws = P_WS();
            pg8::StaticOrder S; S.init(PTOK, INC, gridDim.x, blockIdx.x, ws + WS_H + (size_t)p * ARR, ws + WS_WIN, D, D);
            EpiInProj E{ws, (unsigned char*)P_OUT() + (size_t)p * 2 * ARR, P_IN(4), P_IN(5), P_IN(3), (const f32x2*)(ws + WS_TAB)};
            pg8::gemm_phase(lds, scr, wave, D, D, D, S, E);
            if (BOTH(pb + 0)) GRID_BAR();
        }
        if (IN(pb + 1)) {
            unsigned char* ws = P_WS(); unsigned char* dop = (unsigned char*)P_OUT() + (size_t)p * 2 * ARR;
            sba::attn_phase(lds, (volatile LAS unsigned*)scr, wave, gridDim.x, blockIdx.x, (bf16_t*)(ws + WS_QS), (const bf16_t*)(ws + WS_KS), (const bf16_t*)(ws + WS_VS), (const bf16_t*)(ws + WS_GS));
            { RetOrder S{0, (int)gridDim.x, (int)blockIdx.x, (const char*)(ws + WS_A2), (const char*)(ws + WS_B2), (const char*)(dop + DO_KT), (const char*)(ws + WS_RK)};
              EpiU E{(bf16_t*)(dop + DO_U)};
              pg8::gemm_phase(lds, scr, wave, 256, 512, 256, S, E); }
            { RetOrder S{1, (int)gridDim.x, (int)blockIdx.x, (const char*)(ws + WS_A2), (const char*)(ws + WS_B2), (const char*)(dop + DO_KT), (const char*)(ws + WS_RK)};
              EpiP E{(bf16_t*)(ws + WS_A2)};
              pg8::gemm_phase(lds, scr, wave, 256, 512, 1024, S, E); }
            if (BOTH(pb + 1)) GRID_BAR();
        }
        if (IN(pb + 2)) {
            unsigned char* ws = P_WS(); unsigned char* dop = (unsigned char*)P_OUT() + (size_t)p * 2 * ARR;
            ret_scan((int)(blockIdx.x * (NWAVES * 64) + wave * 64 + fresh_lane()), (int)(gridDim.x * NWAVES * 64), (const bf16_t*)(dop + DO_U), (bf16_t*)(ws + WS_B2));
            pg8::StaticOrder S; S.init(PTOK, D, gridDim.x, blockIdx.x, ws + WS_QS, ws + WS_WSB, D, D);
            EpiGate<false> E{(const bf16_t*)(ws + WS_MA), nullptr, (bf16_t*)(ws + WS_T1)};
            pg8::gemm_phase(lds, scr, wave, D, D, D, S, E);
            if (BOTH(pb + 2)) GRID_BAR();
        }
        if (IN(pb + 3)) {
            unsigned char* ws = P_WS();
            RetOrder S{2, (int)gridDim.x, (int)blockIdx.x, (const char*)(ws + WS_A2), (const char*)(ws + WS_B2), nullptr, nullptr};
            EpiO E{(bf16_t*)(ws + WS_OB), (const bf16_t*)(ws + WS_GR), P_IN(6)};
            pg8::gemm_phase(lds, scr, wave, 512, 512, 512, S, E);
            if (BOTH(pb + 3)) GRID_BAR();
        }
        if (IN(pb + 4)) {
            unsigned char* ws = P_WS();
            pg8::StaticOrder S; S.init(PTOK, D, gridDim.x, blockIdx.x, ws + WS_OB, ws + WS_WRET, D, D);
            EpiGate<true> E{(const bf16_t*)(ws + WS_MB), (const bf16_t*)(ws + WS_T1), (bf16_t*)(ws + WS_MG)};
            pg8::gemm_phase(lds, scr, wave, D, D, D, S, E);
            if (BOTH(pb + 4)) GRID_BAR();
        }
        if (IN(pb + 5)) {
            unsigned char* ws = P_WS();
            pg8::StaticOrder S; S.init(PTOK, D, gridDim.x, blockIdx.x, ws + WS_MG, ws + WS_WOUT, D, D);
            EpiOut E{P_IN(0) + (size_t)p * PTOK * D, P_OUT() + (size_t)p * PTOK * D};
            pg8::gemm_phase(lds, scr, wave, D, D, D, S, E);
            if (BOTH(pb + 5)) GRID_BAR();
        }
    }
#undef IN
#undef BOTH
#undef GRID_BAR
}

extern "C" void kernel_launch(void* const* d_in, const int* in_sizes, int n_in, void* d_out, int out_size, void* d_ws, size_t ws_size, hipStream_t stream) {
    static int grid = 0;
    if (grid == 0) {
        if (n_in != 10 || in_sizes[0] != NTOK * D || out_size != NTOK * D || ws_size < WS_END) { fprintf(stderr, "kernel_launch: unexpected shapes / workspace (%zu < %zu)\n", ws_size, (size_t)WS_END); grid = -1; return; }
        int dev = 0, cus = 0;
        if (hipGetDevice(&dev) != hipSuccess || hipDeviceGetAttribute(&cus, hipDeviceAttributeMultiprocessorCount, dev) != hipSuccess) { grid = -1; return; }
        if (hipFuncSetAttribute((const void*)fwd, hipFuncAttributeMaxDynamicSharedMemorySize, LDS_BYTES) != hipSuccess) { fprintf(stderr, "kernel_launch: hipFuncSetAttribute failed\n"); grid = -1; return; }
        (void)hipGetLastError();
        grid = cus;
    }
    if (grid < 0) return;
    (void)hipMemsetAsync((char*)d_ws + WS_CTL, 0, CTL_ZERO_BYTES, stream);
    Args a{};
    for (int i = 0; i < 10; ++i) a.in[i] = (const float*)d_in[i];
    a.out = (float*)d_out; a.ws = (unsigned char*)d_ws;
    a.ph_lo = 0; a.ph_hi = NPHASE;
    hipLaunchKernelGGL(fwd, dim3(grid), dim3(NWAVES * 64), LDS_BYTES, stream, a);
}
```

```cpp
#include <hip/hip_runtime.h>
#include <cstdio>
#include <cstdint>

#define LAS __attribute__((address_space(3)))
#define GAS __attribute__((address_space(1)))
typedef unsigned short bf16_t;
typedef short bf16x8 __attribute__((ext_vector_type(8)));
typedef float f32x4 __attribute__((ext_vector_type(4)));
typedef float f32x2 __attribute__((ext_vector_type(2)));
typedef unsigned u32x4 __attribute__((ext_vector_type(4)));
typedef unsigned u32x2 __attribute__((ext_vector_type(2)));

constexpr int D = 1024, BATCH = 4, SEQ = 8192, NTOK = BATCH * SEQ;
constexpr int NPASS = 2, PTOK = NTOK / NPASS;
constexpr int INC = 10240;
constexpr int SBH = 8, SBD = 128, RH = 4, RD = 256;
constexpr float EPS = 1e-6f;
constexpr float QSCALE = 0.12751743082459868f;
constexpr float LN2F = 0.6931471805599453f;
constexpr size_t MiB = 1u << 20;
constexpr size_t WS_CTL = 0, CTL_ZERO_BYTES = 1 * MiB;
constexpr size_t WS_WIN = 1 * MiB, WS_WSB = 21 * MiB, WS_WRET = 23 * MiB, WS_WOUT = 25 * MiB, WS_TAB = 27 * MiB, WS_H = 35 * MiB;
constexpr size_t ARR = (size_t)PTOK * 1024 * 2;
constexpr size_t WS_QS = 99 * MiB, WS_KS = WS_QS + ARR, WS_VS = WS_KS + ARR, WS_GS = WS_VS + ARR, WS_RK = WS_GS + ARR, WS_GR = WS_RK + ARR;
constexpr size_t WS_A2 = WS_GR + ARR, WS_B2 = WS_A2 + 2 * ARR, WS_MA = WS_B2 + 2 * ARR, WS_MB = WS_MA + ARR, WS_END = WS_MB + ARR;
constexpr size_t WS_T1 = WS_KS, WS_MG = WS_VS, WS_OB = WS_RK;
constexpr size_t DO_KT = 0, DO_U = ARR;
constexpr int RUNITS = 2 * RH * 32;
constexpr int CW_BAR = 4096;
constexpr int RING_BYTES = 131072, SCR_OFF = RING_BYTES, TRS_BYTES = 16384  , CST_OFF = SCR_OFF + TRS_BYTES, CST_BYTES = 9216  , MISC_OFF = CST_OFF + CST_BYTES, LDS_BYTES = 157696;
constexpr int NWAVES = 8;

__device__ const float INVF[128] = {
1.0f, 0.930572033f, 0.865964353f, 0.805842161f, 0.749894261f, 0.697830617f, 0.649381638f, 0.604296386f, 0.562341332f, 0.523299098f, 0.486967534f, 0.453158379f, 0.421696514f, 0.392418981f, 0.365174115f, 0.339820832f, 0.316227764f, 0.294272691f, 0.273841977f, 0.254829675f, 0.237137377f, 0.220673412f, 0.2053525f, 0.191095307f, 0.177827939f, 0.165481716f, 0.153992653f, 0.143301249f, 0.133352131f, 0.124093778f, 0.115478203f, 0.107460782f, 0.100000001f, 0.0930572078f, 0.0865964293f, 0.0805842131f, 0.0749894157f, 0.0697830617f, 0.0649381652f, 0.0604296401f, 0.0562341325f, 0.0523299128f, 0.0486967526f, 0.0453158356f, 0.0421696529f, 0.0392418951f, 0.0365174115f, 0.0339820832f, 0.0316227749f, 0.0294272713f, 0.0273841973f, 0.0254829675f, 0.0237137377f, 0.0220673401f, 0.0205352511f, 0.0191095285f, 0.0177827943f, 0.0165481698f, 0.0153992651f, 0.0143301254f, 0.0133352149f, 0.0124093778f, 0.0115478206f, 0.0107460786f, 0.00999999978f, 0.00930572022f, 0.00865964312f, 0.00805842225f, 0.00749894185f, 0.00697830599f, 0.00649381615f, 0.00604296383f, 0.00562341325f, 0.00523299119f, 0.00486967526f, 0.00453158328f, 0.00421696482f, 0.0039241896f, 0.00365174119f, 0.00339820841f, 0.00316227763f, 0.00294272718f, 0.00273841969f, 0.00254829694f, 0.00237137359f, 0.00220673415f, 0.00205352483f, 0.00191095297f, 0.00177827943f, 0.00165481714f, 0.00153992651f, 0.00143301254f, 0.00133352145f, 0.00124093774f, 0.0011547819f, 0.00107460783f, 0.00100000005f, 0.000930572045f, 0.000865964335f, 0.000805842166f, 0.000749894243f, 0.000697830576f, 0.000649381662f, 0.000604296394f, 0.000562341302f, 0.000523299095f, 0.000486967532f, 0.000453158369f, 0.000421696517f, 0.000392418966f, 0.000365174143f, 0.000339820836f, 0.000316227757f, 0.000294272701f, 0.000273841957f, 0.000254829676f, 0.00023713737f, 0.000220673406f, 0.00020535251f, 0.0001910953f, 0.00017782794f, 0.000165481717f, 0.000153992645f, 0.000143301251f, 0.00013335215f, 0.000124093771f, 0.0001154782f, 0.000107460786f };
__device__ __forceinline__ float log2gamma(int h) { return h == 0 ? -0.04580368961312479f : h == 1 ? -0.02272007650008353f : h == 2 ? -0.011315313227834146f : -0.005646563141142063f; }

__device__ __forceinline__ unsigned cvt_pk_bf16(float lo, float hi) { unsigned r; asm volatile("v_cvt_pk_bf16_f32 %0, %1, %2" : "=v"(r) : "v"(lo), "v"(hi)); return r; }
__device__ __forceinline__ float bf_lo(unsigned w) { return __uint_as_float(w << 16); }
__device__ __forceinline__ float bf_hi(unsigned w) { return __uint_as_float(w & 0xffff0000u); }
__device__ __forceinline__ float wave_sum(float v) {
#pragma unroll
    for (int o = 1; o < 64; o <<= 1) v += __shfl_xor(v, o);
    return v;
}
__device__ __forceinline__ float fast_sigmoid(float v) { return __builtin_amdgcn_rcpf(1.0f + __builtin_amdgcn_exp2f(-1.4426950408889634f * v)); }
__device__ __forceinline__ int fresh_lane() { int z = 0; asm volatile("" : "+v"(z)); return (int)__builtin_amdgcn_mbcnt_hi(~0u, __builtin_amdgcn_mbcnt_lo(~0u, (unsigned)z)); }
__device__ __forceinline__ float sum_fq(float s) {
    s += __builtin_bit_cast(float, __builtin_amdgcn_ds_swizzle(__builtin_bit_cast(int, s), 0x401F));
    const auto rr = __builtin_amdgcn_permlane32_swap(__float_as_uint(s), __float_as_uint(s), false, false);
    return __uint_as_float(rr[0]) + __uint_as_float(rr[1]);
}
#define LDS_WAIT() asm volatile("s_waitcnt lgkmcnt(0)" ::: "memory")
#define VM_WAIT() asm volatile("s_waitcnt vmcnt(0)" ::: "memory")

namespace pg8 {
constexpr int BM = 256, BK = 64, HALF = 128, HTB = HALF * BK * 2, STAGE_BYTES = 8 * HTB;
__host__ __device__ __forceinline__ int lds_byte(int r, int c) { const int st = (r >> 4) * 2 + (c >> 5), rr = r & 15, cc = c & 31, ob = rr * 64 + cc * 2; return st * 1024 + (ob ^ (((ob >> 9) & 1) << 5)); }
__host__ __device__ __forceinline__ void stage_rc(int b, int& R, int& C) { const int st = b / 1024, sb = b % 1024, swz = sb ^ (((sb >> 9) & 1) << 5); R = (st >> 1) * 16 + swz / 64; C = (st & 1) * 32 + (swz % 64) / 2; }
__host__ __device__ __forceinline__ int perm32(int rho) { const int n = rho >> 4, i = rho & 15; return 8 * (i >> 2) + 4 * n + (i & 3); }
struct Unit { int pm, pn; };

struct StaticOrder {
    int nM, nN, nwg, G, c, pn0; const char* A; const char* B; size_t tA, tB;
    __device__ void init(int M, int N, int G_, int c_, const void* A_, const void* B_, int lda, int ldb, int pn0_ = 0) { pn0 = pn0_; nM = M / BM; nN = N / BM; nwg = nM * nN; G = G_; c = c_; A = (const char*)A_; B = (const char*)B_; tA = (size_t)BM * lda * 2; tB = (size_t)BM * ldb * 2; }
    __device__ bool next(int i, Unit& u) const {
        const long L = (long)i * G + c; if (L >= nwg) return false;
        int wgid = (int)L; { const int q = nwg / 8, r = nwg % 8, xcd = wgid % 8, off = wgid / 8; wgid = (xcd < r ? xcd * (q + 1) : r * (q + 1) + (xcd - r) * q) + off; }
        const int nig = 8 * nN, gid = wgid / nig, fm = gid * 8, gsz = (nM - fm) < 8 ? (nM - fm) : 8;
        u.pm = fm + ((wgid % nig) % gsz); u.pn = pn0 + (wgid % nig) / gsz; return true;
    }
    __device__ __forceinline__ void ptrs(const Unit& u, const char*& a, const char*& b) const { a = A + (size_t)u.pm * tA; b = B + (size_t)(u.pn - pn0) * tB; }
};

template <class Epi, class Sched>
__device__ __forceinline__ void gemm_phase(LAS unsigned char* lds, LAS unsigned char* scr, int wid, const int K, const int lda, const int ldb, const Sched& S, const Epi& E) {
    asm volatile("" : "+s"(wid));
    const int lane = fresh_lane(), tid = wid * 64 + lane;
    const int wr = wid >> 2, wc = wid & 3, fr = lane & 15, fq = lane >> 4;
    const int nt = K / BK;
    unsigned v_offA, v_offB;
    { int R, C; stage_rc(tid * 16, R, C); const int Rb = (R & ~31) + perm32(R & 31); v_offA = (unsigned)(R * lda + C) * 2u; v_offB = (unsigned)(Rb * ldb + C) * 2u; }
    const size_t r64_offA = (size_t)64 * lda * 2, r64_offB = (size_t)64 * ldb * 2;
    const size_t kstep = (size_t)(BK * 2);
    const size_t hstepA = (size_t)HALF * lda * 2, hstepB = (size_t)HALF * ldb * 2;
    const unsigned ldsw = (unsigned)wid * 1024u;
    int aoff = lds_byte(wr * 64 + fr, fq * 8), boff = lds_byte(wc * 32 + fr, fq * 8);
#define PG8_SA(b, h) (((b) * 2 + (h)) * HTB)
#define PG8_SB(b, h) ((4 + (b) * 2 + (h)) * HTB)
#define PG8_STAGE(bufoff, gbase, voff) do { _Pragma("unroll") for (int _i = 0; _i < 2; ++_i) \
        __builtin_amdgcn_global_load_lds((const unsigned*)((const char*)(gbase) + (size_t)_i * r64_##voff + v_##voff), (LAS unsigned*)(lds + (bufoff) + ldsw + _i * 8192), 16, 0, 0); } while (0)
#define PG8_LDA(dst, b, h) do { _Pragma("unroll") for (int m = 0; m < 4; ++m) _Pragma("unroll") for (int k = 0; k < 2; ++k) dst[m][k] = *(const LAS bf16x8*)(lds + PG8_SA(b, h) + aoff + m * 2048 + k * 1024); } while (0)
#define PG8_LDB(dst, b, h) do { _Pragma("unroll") for (int n = 0; n < 2; ++n) _Pragma("unroll") for (int k = 0; k < 2; ++k) dst[n][k] = *(const LAS bf16x8*)(lds + PG8_SB(b, h) + boff + n * 2048 + k * 1024); } while (0)
#define PG8_MMA(ai, bj, At, Bt) do { __builtin_amdgcn_s_setprio(1); _Pragma("unroll") for (int m = 0; m < 4; ++m) _Pragma("unroll") for (int n = 0; n < 2; ++n) _Pragma("unroll") for (int k = 0; k < 2; ++k) \
        acc[ai][bj][m][n] = __builtin_amdgcn_mfma_f32_16x16x32_bf16(Bt[n][k], At[m][k], acc[ai][bj][m][n], 0, 0, 0); __builtin_amdgcn_s_setprio(0); } while (0)
#define PG8_WAIT_V(n) asm volatile("s_waitcnt vmcnt(" #n ")" ::: "memory")
#define PG8_WAIT_L(n) asm volatile("s_waitcnt lgkmcnt(" #n ")" ::: "memory")
#define PG8_BAR __builtin_amdgcn_s_barrier()
#define PG8_SCHED __builtin_amdgcn_sched_barrier(0)
    Unit cur, nxt; int ui = 0;
    if (!S.next(0, cur)) return;
    f32x4 acc[2][2][4][2];
#pragma unroll
    for (int a = 0; a < 2; ++a)
#pragma unroll
        for (int b = 0; b < 2; ++b)
#pragma unroll
            for (int m = 0; m < 4; ++m)
#pragma unroll
                for (int n = 0; n < 2; ++n) acc[a][b][m][n] = (f32x4){0.f, 0.f, 0.f, 0.f};
    bf16x8 At[4][2], B0[2][2], B1[2][2];
    const char* cA; const char* cB; S.ptrs(cur, cA, cB);
    PG8_STAGE(PG8_SB(0, 0), cB, offB); PG8_STAGE(PG8_SB(0, 1), cB + hstepB, offB); PG8_STAGE(PG8_SA(0, 0), cA, offA); PG8_STAGE(PG8_SA(0, 1), cA + hstepA, offA);
    if (wr == 1) PG8_BAR;
    PG8_WAIT_V(2); PG8_BAR;
    PG8_STAGE(PG8_SB(1, 0), cB + kstep, offB); PG8_STAGE(PG8_SA(1, 0), cA + kstep, offA); PG8_STAGE(PG8_SB(1, 1), cB + hstepB + kstep, offB);
    PG8_WAIT_V(6); PG8_BAR;
    for (;;) {
        if (ui > 0) {
            const int l2 = fresh_lane(), t2 = wid * 64 + l2;
            { int R, C; stage_rc(t2 * 16, R, C); const int Rb = (R & ~31) + perm32(R & 31); v_offA = (unsigned)(R * lda + C) * 2u; v_offB = (unsigned)(Rb * ldb + C) * 2u; }
            aoff = lds_byte(wr * 64 + (l2 & 15), (l2 >> 4) * 8); boff = lds_byte(wc * 32 + (l2 & 15), (l2 >> 4) * 8);
        }
        const bool has_next = S.next(ui + 1, nxt);
        const char* nA = cA; const char* nB = cB; if (has_next) S.ptrs(nxt, nA, nB);
        for (int t = 0; t < nt; t += 2) {
            const bool last = (t == nt - 2);
            const char* a1 = cA + (size_t)(t + 1) * kstep;
            const char* a2 = last ? nA : cA + (size_t)(t + 2) * kstep; const char* b2 = last ? nB : cB + (size_t)(t + 2) * kstep;
            const char* a3 = a2 + kstep; const char* b3 = b2 + kstep;
            PG8_LDB(B0, 0, 0); PG8_LDB(B1, 0, 1); PG8_SCHED; PG8_LDA(At, 0, 0); PG8_STAGE(PG8_SA(1, 1), a1 + hstepA, offA);
            PG8_WAIT_V(8); PG8_WAIT_L(0); PG8_BAR; PG8_MMA(0, 0, At, B0); PG8_MMA(0, 1, At, B1); PG8_BAR; PG8_SCHED;
            PG8_LDA(At, 0, 1); PG8_STAGE(PG8_SB(0, 0), b2, offB); PG8_STAGE(PG8_SB(0, 1), b2 + hstepB, offB); PG8_STAGE(PG8_SA(0, 0), a2, offA);
            PG8_WAIT_V(8); PG8_WAIT_L(0); PG8_BAR; PG8_MMA(1, 0, At, B0); PG8_MMA(1, 1, At, B1); PG8_BAR; PG8_SCHED;
            PG8_LDB(B0, 1, 0); PG8_LDB(B1, 1, 1); PG8_SCHED; PG8_LDA(At, 1, 0); PG8_STAGE(PG8_SA(0, 1), a2 + hstepA, offA);
            PG8_WAIT_V(8); PG8_WAIT_L(0); PG8_BAR; PG8_MMA(0, 0, At, B0); PG8_MMA(0, 1, At, B1); PG8_BAR; PG8_SCHED;
            PG8_LDA(At, 1, 1); PG8_STAGE(PG8_SB(1, 0), b3, offB); PG8_STAGE(PG8_SB(1, 1), b3 + hstepB, offB); PG8_STAGE(PG8_SA(1, 0), a3, offA);
            PG8_WAIT_V(8); PG8_WAIT_L(0); PG8_BAR; PG8_MMA(1, 0, At, B0); PG8_MMA(1, 1, At, B1); PG8_BAR; PG8_SCHED;
        }
        if (wr == 0) PG8_BAR;
        { const int lane_ = fresh_lane();
          E(acc, cur, wr, wc, lane_ & 15, lane_ >> 4, scr, wid, lane_); }
        if (!has_next) break;
#pragma unroll
        for (int a = 0; a < 2; ++a)
#pragma unroll
            for (int b = 0; b < 2; ++b)
#pragma unroll
                for (int m = 0; m < 4; ++m)
#pragma unroll
                    for (int n = 0; n < 2; ++n) acc[a][b][m][n] = (f32x4){0.f, 0.f, 0.f, 0.f};
        cur = nxt; cA = nA; cB = nB; ++ui;
        if (wr == 1) PG8_BAR;
    }
    PG8_WAIT_V(0);
    PG8_BAR;
#undef PG8_SA
#undef PG8_SB
#undef PG8_STAGE
#undef PG8_LDA
#undef PG8_LDB
#undef PG8_MMA
#undef PG8_WAIT_V
#undef PG8_WAIT_L
#undef PG8_BAR
#undef PG8_SCHED
}
}

typedef f32x4 AccT[2][2][4][2];
__device__ __forceinline__ void st8(bf16_t* p, const f32x4& v0, const f32x4& v1) {
    u32x4 w; w.x = cvt_pk_bf16(v0[0], v0[1]); w.y = cvt_pk_bf16(v0[2], v0[3]); w.z = cvt_pk_bf16(v1[0], v1[1]); w.w = cvt_pk_bf16(v1[2], v1[3]);
    *(u32x4*)p = w;
}
__device__ __forceinline__ void st_rows(bf16_t* O, int prow, int col, const f32x4 (&v)[2][2]) { bf16_t* rowp = O + (size_t)prow * 1024 + col; st8(rowp, v[0][0], v[0][1]); st8(rowp + 128, v[1][0], v[1][1]); }
template <bool DEC> __device__ __forceinline__ void st_transposed(AccT& acc, bf16_t* dst, int pitch, float l2g, float scale, int wr, int wc, int fr, int fq, LAS unsigned char* scr, int wid, int lane) {
    LAS bf16_t* T = (LAS bf16_t*)(scr + wid * 2048);
    const int dl = lane >> 2, part = lane & 3;
#pragma unroll
    for (int ai = 0; ai < 2; ++ai) {
        float dk[4];
#pragma unroll
        for (int m = 0; m < 4; ++m) dk[m] = DEC ? scale * __builtin_amdgcn_exp2f(l2g * (float)(255 - (ai * 128 + wr * 64 + m * 16 + fr))) : 1.0f;
#pragma unroll
        for (int bj = 0; bj < 2; ++bj)
#pragma unroll
            for (int n = 0; n < 2; ++n) {
                int zz = 0; asm volatile("" : "+v"(zz) :: "memory");
#pragma unroll
                for (int m = 0; m < 4; ++m)
#pragma unroll
                    for (int j = 0; j < 4; j += 2) { const unsigned w2 = cvt_pk_bf16(acc[ai][bj][m][n][j] * dk[m], acc[ai][bj][m][n][j + 1] * dk[m]);
                        T[(4 * fq + j + zz) * 64 + 16 * m + fr] = (bf16_t)(w2 & 0xffffu); T[(4 * fq + j + 1) * 64 + 16 * m + fr] = (bf16_t)(w2 >> 16); }
                LDS_WAIT(); asm volatile("" ::: "memory");
                const u32x4 r0 = *(const LAS u32x4*)(T + dl * 64 + 16 * part), r1 = *(const LAS u32x4*)(T + dl * 64 + 16 * part + 8);
                const int d = bj * 128 + wc * 32 + 8 * (dl >> 2) + 4 * n + (dl & 3);
                bf16_t* gp = dst + (size_t)d * pitch + ai * 128 + wr * 64 + 16 * part;
                *(u32x4*)gp = r0; *(u32x4*)(gp + 8) = r1;
                LDS_WAIT(); asm volatile("" ::: "memory");
            }
    }
}
struct EpiQKNorm {
    unsigned char* ws;
    __device__ __forceinline__ void operator()(AccT& acc, const pg8::Unit& u, int wr, int wc, int fr, int fq, LAS unsigned char* scr, int wid, int lane) const {
        const int seg = u.pn >> 2, ct = u.pn & 3;
        const int rt0 = wr * 64 + fr, cw = wc * 32 + 8 * fq, col = ct * 256 + cw;
        const LAS float* cst = (const LAS float*)(scr + TRS_BYTES);
#define ROWGROUPS(BODY) _Pragma("unroll") for (int ai = 0; ai < 2; ++ai) _Pragma("unroll") for (int m = 0; m < 4; ++m) { \
            int zz = 0; asm volatile("" : "+v"(zz) :: "memory"); const int rt = ai * 128 + rt0 + m * 16 + zz; const int prow = u.pm * 256 + rt; \
            f32x4 v[2][2]; _Pragma("unroll") for (int bj = 0; bj < 2; ++bj) { v[bj][0] = acc[ai][bj][m][0]; v[bj][1] = acc[ai][bj][m][1]; } BODY }
        {
            LAS float* P = (LAS float*)scr;
#pragma unroll
            for (int ai = 0; ai < 2; ++ai)
#pragma unroll
                for (int m = 0; m < 4; ++m)
#pragma unroll
                    for (int bj = 0; bj < 2; ++bj) {
                        const f32x4 a = acc[ai][bj][m][0], b = acc[ai][bj][m][1];
                        float s = (a[0] * a[0] + a[1] * a[1]) + (a[2] * a[2] + a[3] * a[3]) + (b[0] * b[0] + b[1] * b[1]) + (b[2] * b[2] + b[3] * b[3]);
                        s = sum_fq(s);
                        if (fq == 0) P[(ai * 128 + rt0 + m * 16) * 8 + bj * 4 + wc] = s;
                    }
            LDS_WAIT(); __builtin_amdgcn_s_barrier(); asm volatile("" ::: "memory");
            const f32x4 g0 = *(const LAS f32x4*)(cst + seg * 128 + cw), g1 = *(const LAS f32x4*)(cst + seg * 128 + cw + 4);
            const float sc = (seg == 0) ? QSCALE : 1.0f;
            bf16_t* O = (bf16_t*)(ws + (seg == 0 ? WS_QS : WS_KS));
            ROWGROUPS(
                _Pragma("unroll") for (int bj = 0; bj < 2; ++bj) {
                    const f32x4 p = *(const LAS f32x4*)(P + rt * 8 + bj * 4);
                    const float rs = sc / sqrtf(((p[0] + p[1]) + (p[2] + p[3])) * (1.0f / 128.0f) + EPS);
                    v[bj][0] = v[bj][0] * g0 * rs; v[bj][1] = v[bj][1] * g1 * rs; }
                st_rows(O, prow, col, v); )
        }
#undef ROWGROUPS
    }
};
struct EpiInProj {
    unsigned char* ws; unsigned char* dop; const f32x2* tab;
    __device__ __forceinline__ void operator()(AccT& acc, const pg8::Unit& u, int wr, int wc, int fr, int fq, LAS unsigned char* scr, int wid, int lane) const {
        const int seg = u.pn >> 2, ct = u.pn & 3;
        const int rt0 = wr * 64 + fr;
        const int cw = wc * 32 + 8 * fq;
        const int col = ct * 256 + cw;
        const LAS float* cst = (const LAS float*)(scr + TRS_BYTES);
#define ROWGROUPS(BODY) _Pragma("unroll") for (int ai = 0; ai < 2; ++ai) _Pragma("unroll") for (int m = 0; m < 4; ++m) { \
            int zz = 0; asm volatile("" : "+v"(zz) :: "memory"); const int rt = ai * 128 + rt0 + m * 16 + zz; const int prow = u.pm * 256 + rt; \
            f32x4 v[2][2]; _Pragma("unroll") for (int bj = 0; bj < 2; ++bj) { v[bj][0] = acc[ai][bj][m][0]; v[bj][1] = acc[ai][bj][m][1]; } BODY }
        if (seg == 4 || seg == 5) {
            asm volatile("" ::: "memory");
            const float l2g = log2gamma(ct);
            const int bl = (u.pm * 256) >> 13, sc0 = ((u.pm * 256) & (SEQ - 1)) >> 8;
            const size_t ru = (size_t)((bl * RH + ct) * 32 + sc0);
            const char* tabc = (const char*)tab;
#pragma unroll
            for (int ai = 0; ai < 2; ++ai)
#pragma unroll
                for (int n = 0; n < 2; ++n) {
                    int zz = 0; asm volatile("" : "+v"(zz) :: "memory");
                    f32x4 tb[4][2];
#pragma unroll
                    for (int m = 0; m < 4; ++m) { const unsigned pos = (unsigned)((u.pm * 256 + ai * 128 + rt0 + m * 16 + zz) & (SEQ - 1)); const unsigned off = (pos * 128u + (unsigned)(cw + 4 * n)) * 8u;
                        tb[m][0] = *(const f32x4*)(tabc + off); tb[m][1] = *(const f32x4*)(tabc + off + 16u); }
#pragma unroll
                    for (int m = 0; m < 4; ++m) {
                        const f32x4 c4 = tb[m][0], s4 = tb[m][1], x1 = acc[ai][0][m][n], x2 = acc[ai][1][m][n];
                        acc[ai][0][m][n] = x1 * c4 - x2 * s4; acc[ai][1][m][n] = x1 * s4 + x2 * c4;
                        asm volatile("" : "+v"(acc[ai][0][m][n]), "+v"(acc[ai][1][m][n]));
                    }
                }
#pragma unroll
            for (int ai = 0; ai < 2; ++ai)
#pragma unroll
                for (int m = 0; m < 4; ++m) {
                    int zz = 0; asm volatile("" : "+v"(zz) :: "memory");
                    const int idx = ai * 128 + rt0 + m * 16 + zz;
                    const float df = (seg == 4) ? __builtin_amdgcn_exp2f(l2g * (float)(idx + 1)) : 0.0625f * __builtin_amdgcn_exp2f(-l2g * (float)(idx + 1));
                    bf16_t* rowp = (seg == 4) ? (bf16_t*)(ws + WS_A2) + (ru * 256 + idx) * 512 + 256 + cw : (bf16_t*)(ws + WS_RK) + (size_t)(u.pm * 256 + idx) * 1024 + col;
                    st8(rowp, acc[ai][0][m][0] * df, acc[ai][0][m][1] * df); st8(rowp + 128, acc[ai][1][m][0] * df, acc[ai][1][m][1] * df);
                }
            if (seg == 5) st_transposed<true>(acc, (bf16_t*)(dop + DO_KT) + ru * 256 * 256, 256, l2g, 0.0625f, wr, wc, fr, fq, scr, wid, lane);
        } else if (seg == 6) {
            asm volatile("" ::: "memory");
            const int bl = (u.pm * 256) >> 13, sc0 = ((u.pm * 256) & (SEQ - 1)) >> 8;
            const size_t ru = (size_t)((bl * RH + ct) * 32 + sc0);
            st_transposed<false>(acc, (bf16_t*)(ws + WS_B2) + ru * 256 * 512, 512, 0.f, 1.f, wr, wc, fr, fq, scr, wid, lane);
        } else if (seg == 3 || seg == 7) {
            asm volatile("" ::: "memory");
            bf16_t* O = (bf16_t*)(ws + (seg == 3 ? WS_GS : WS_GR));
            ROWGROUPS(
                _Pragma("unroll") for (int bj = 0; bj < 2; ++bj)
                    _Pragma("unroll") for (int j = 0; j < 4; ++j) { v[bj][0][j] = v[bj][0][j] * fast_sigmoid(v[bj][0][j]); v[bj][1][j] = v[bj][1][j] * fast_sigmoid(v[bj][1][j]); }
                st_rows(O, prow, col, v); )
        } else if (seg >= 8) {
            asm volatile("" ::: "memory");
            bf16_t* O = (bf16_t*)(ws + (seg == 8 ? WS_MA : WS_MB));
            const LAS float* bp = cst + 256 + (seg - 8) * 1024 + col;
            f32x4 c0[2], c1[2];
            c0[0] = *(const LAS f32x4*)bp; c1[0] = *(const LAS f32x4*)(bp + 4); c0[1] = *(const LAS f32x4*)(bp + 128); c1[1] = *(const LAS f32x4*)(bp + 132);
            ROWGROUPS(
                _Pragma("unroll") for (int bj = 0; bj < 2; ++bj)
                    _Pragma("unroll") for (int j = 0; j < 4; ++j) { v[bj][0][j] = fast_sigmoid(v[bj][0][j] + c0[bj][j]); v[bj][1][j] = fast_sigmoid(v[bj][1][j] + c1[bj][j]); }
                st_rows(O, prow, col, v); )
        } else {
            bf16_t* O = (bf16_t*)(ws + WS_VS);
            ROWGROUPS( st_rows(O, prow, col, v); )
        }
#undef ROWGROUPS
    }
};
template <bool ADD> struct EpiGate {
    const bf16_t* gate; const bf16_t* prev; bf16_t* out;
    __device__ __forceinline__ void operator()(AccT& acc, const pg8::Unit& u, int wr, int wc, int fr, int fq, LAS unsigned char* scr, int wid, int lane) const {
#pragma unroll
        for (int ai = 0; ai < 2; ++ai)
#pragma unroll
            for (int m = 0; m < 4; ++m) {
                const size_t off = (size_t)(u.pm * 256 + ai * 128 + wr * 64 + m * 16 + fr) * 1024 + u.pn * 256 + wc * 32 + 8 * fq;
#pragma unroll
                for (int bj = 0; bj < 2; ++bj) {
                    const u32x4 g = *(const u32x4*)(gate + off + bj * 128);
                    f32x4 v0 = acc[ai][bj][m][0], v1 = acc[ai][bj][m][1];
                    v0[0] *= bf_lo(g.x); v0[1] *= bf_hi(g.x); v0[2] *= bf_lo(g.y); v0[3] *= bf_hi(g.y);
                    v1[0] *= bf_lo(g.z); v1[1] *= bf_hi(g.z); v1[2] *= bf_lo(g.w); v1[3] *= bf_hi(g.w);
                    if (ADD) { const u32x4 p = *(const u32x4*)(prev + off + bj * 128);
                        v0[0] += bf_lo(p.x); v0[1] += bf_hi(p.x); v0[2] += bf_lo(p.y); v0[3] += bf_hi(p.y);
                        v1[0] += bf_lo(p.z); v1[1] += bf_hi(p.z); v1[2] += bf_lo(p.w); v1[3] += bf_hi(p.w); }
                    st8(out + off + bj * 128, v0, v1);
                }
            }
    }
};
struct EpiOut {
    const float* x; float* out;
    __device__ __forceinline__ void operator()(AccT& acc, const pg8::Unit& u, int wr, int wc, int fr, int fq, LAS unsigned char* scr, int wid, int lane) const {
#pragma unroll
        for (int ai = 0; ai < 2; ++ai)
#pragma unroll
            for (int m = 0; m < 4; ++m) {
                const size_t off = (size_t)(u.pm * 256 + ai * 128 + wr * 64 + m * 16 + fr) * 1024 + u.pn * 256 + wc * 32 + 8 * fq;
#pragma unroll
                for (int bj = 0; bj < 2; ++bj)
#pragma unroll
                    for (int n = 0; n < 2; ++n) { const f32x4 xv = *(const f32x4*)(x + off + bj * 128 + 4 * n); *(f32x4*)(out + off + bj * 128 + 4 * n) = xv + acc[ai][bj][m][n]; }
            }
    }
};

struct RetOrder {
    int mode, G, c; const char* A2; const char* B2; const char* KT; const char* RKp;
    __device__ bool next(int i, pg8::Unit& u) const { const int id = c + i * G; if (id >= RUNITS) return false; u.pm = id; u.pn = 0; return true; }
    __device__ __forceinline__ void ptrs(const pg8::Unit& u, const char*& a, const char*& b) const {
        const size_t t2 = (size_t)u.pm * (256 * 512 * 2);
        if (mode == 0) { a = B2 + t2; b = KT + (size_t)u.pm * (256 * 256 * 2); }
        else if (mode == 1) { const int bl = u.pm >> 7, h = (u.pm >> 5) & 3, N = u.pm & 31; a = A2 + t2 + 512; b = RKp + ((size_t)(bl * SEQ + N * 256) * 1024 + h * RD) * 2; }
        else { a = A2 + t2; b = B2 + t2; }
    }
};
struct EpiU {
    bf16_t* U;
    __device__ __forceinline__ void operator()(AccT& acc, const pg8::Unit& u, int wr, int wc, int fr, int fq, LAS unsigned char* scr, int wid, int lane) const {
#pragma unroll
        for (int ai = 0; ai < 2; ++ai)
#pragma unroll
            for (int m = 0; m < 4; ++m) {
                bf16_t* rowp = U + ((size_t)u.pm * 256 + ai * 128 + wr * 64 + m * 16 + fr) * 256 + wc * 32 + 8 * fq;
                st8(rowp, acc[ai][0][m][0], acc[ai][0][m][1]); st8(rowp + 128, acc[ai][1][m][0], acc[ai][1][m][1]);
            }
    }
};
struct EpiP {
    bf16_t* A2;
    __device__ __forceinline__ void operator()(AccT& acc, const pg8::Unit& u, int wr, int wc, int fr, int fq, LAS unsigned char* scr, int wid, int lane) const {
        const float l2g2 = 2.0f * log2gamma((u.pm >> 5) & 3);
#pragma unroll
        for (int ai = 0; ai < 2; ++ai)
#pragma unroll
            for (int m = 0; m < 4; ++m) {
                int zz = 0; asm volatile("" : "+v"(zz) :: "memory");
                const int t = ai * 128 + wr * 64 + m * 16 + fr + zz;
                bf16_t* rowp = A2 + ((size_t)u.pm * 256 + t) * 512 + wc * 32 + 8 * fq;
#pragma unroll
                for (int bj = 0; bj < 2; ++bj) {
                    const int crel = (2 * bj + (wc >> 1)) - (2 * ai + wr);
                    f32x4 v[2];
                    if (crel > 0) { v[0] = v[1] = (f32x4){0.f, 0.f, 0.f, 0.f}; }
                    else if (crel < 0) { v[0] = acc[ai][bj][m][0]; v[1] = acc[ai][bj][m][1]; }
                    else {
#pragma unroll
                        for (int n = 0; n < 2; ++n)
#pragma unroll
                            for (int j = 0; j < 4; ++j) {
                                const int s = bj * 128 + wc * 32 + 8 * fq + 4 * n + j;
                                const float dm = (s > t) ? __builtin_amdgcn_exp2f(l2g2 * (float)(s - t)) : 1.0f;
                                v[n][j] = acc[ai][bj][m][n][j] * dm;
                            }
                    }
                    st8(rowp + bj * 128, v[0], v[1]);
                }
            }
    }
};
struct EpiO {
    bf16_t* OB; const bf16_t* GR; const float* rgain;
    __device__ __forceinline__ void operator()(AccT& acc, const pg8::Unit& u, int wr, int wc, int fr, int fq, LAS unsigned char* scr, int wid, int lane) const {
        const int bl = u.pm >> 7, h = (u.pm >> 5) & 3, N = u.pm & 31;
        LAS float* P = (LAS float*)scr;
#pragma unroll
        for (int ai = 0; ai < 2; ++ai)
#pragma unroll
            for (int m = 0; m < 4; ++m) {
                float s = 0.f;
#pragma unroll
                for (int bj = 0; bj < 2; ++bj)
#pragma unroll
                    for (int n = 0; n < 2; ++n) { const f32x4 a = acc[ai][bj][m][n]; s += (a[0] * a[0] + a[1] * a[1]) + (a[2] * a[2] + a[3] * a[3]); }
                s = sum_fq(s);
                if (fq == 0) P[(ai * 128 + wr * 64 + m * 16 + fr) * 4 + wc] = s;
            }
        LDS_WAIT(); __builtin_amdgcn_s_barrier(); asm volatile("" ::: "memory");
        const float* gp = rgain + h * RD + wc * 32 + 8 * fq;
        f32x4 g[2][2];
#pragma unroll
        for (int bj = 0; bj < 2; ++bj) { g[bj][0] = *(const f32x4*)(gp + bj * 128); g[bj][1] = *(const f32x4*)(gp + bj * 128 + 4); }
#pragma unroll
        for (int ai = 0; ai < 2; ++ai)
#pragma unroll
            for (int m = 0; m < 4; ++m) {
                int zz = 0; asm volatile("" : "+v"(zz) :: "memory");
                const int t = ai * 128 + wr * 64 + m * 16 + fr + zz;
                const f32x4 p = *(const LAS f32x4*)(P + t * 4);
                const float rs = 1.0f / sqrtf(((p[0] + p[1]) + (p[2] + p[3])) * (1.0f / RD) + EPS);
                const size_t off = ((size_t)(bl * SEQ + N * 256 + t)) * 1024 + h * RD + wc * 32 + 8 * fq;
#pragma unroll
                for (int bj = 0; bj < 2; ++bj) {
                    const u32x4 gt = *(const u32x4*)(GR + off + bj * 128);
                    f32x4 v0 = acc[ai][bj][m][0] * g[bj][0] * rs, v1 = acc[ai][bj][m][1] * g[bj][1] * rs;
                    v0[0] *= bf_lo(gt.x); v0[1] *= bf_hi(gt.x); v0[2] *= bf_lo(gt.y); v0[3] *= bf_hi(gt.y);
                    v1[0] *= bf_lo(gt.z); v1[1] *= bf_hi(gt.z); v1[2] *= bf_lo(gt.w); v1[3] *= bf_hi(gt.w);
                    st8(OB + off + bj * 128, v0, v1);
                }
            }
    }
};
__device__ __forceinline__ void ret_scan(int gtid, int nthreads, const bf16_t* U, bf16_t* B2) {
    asm volatile("" : "+v"(gtid));
    for (int it = gtid; it < 2 * RH * 256 * 64; it += nthreads) {
        const int dk4 = it & 63, dv = (it >> 6) & 255, bh = it >> 14;
        const float g256 = __builtin_amdgcn_exp2f(256.0f * log2gamma(bh & 3));
        const bf16_t* up = U + ((size_t)(bh * 32) * 256 + dv) * 256 + 4 * dk4;
        bf16_t* sp = B2 + ((size_t)(bh * 32) * 256 + dv) * 512 + 256 + 4 * dk4;
        float s0 = 0.f, s1 = 0.f, s2 = 0.f, s3 = 0.f;
#pragma unroll 8
        for (int N = 0; N < 32; ++N) {
            u32x2 o; o.x = cvt_pk_bf16(s0, s1); o.y = cvt_pk_bf16(s2, s3);
            *(u32x2*)(sp + (size_t)N * 256 * 512) = o;
            const u32x2 uv = *(const u32x2*)(up + (size_t)N * 256 * 256);
            s0 = g256 * s0 + bf_lo(uv.x); s1 = g256 * s1 + bf_hi(uv.x); s2 = g256 * s2 + bf_lo(uv.y); s3 = g256 * s3 + bf_hi(uv.y);
        }
    }
}

#define XB_TMO      128
#define XB_XCNT(j)  (256  + 64 * (j))
#define XB_XSUB(j)  (1280 + 64 * (j))
#define XB_XGEN(j)  (2304 + 64 * (j))
#define XB_TOP      3328
#define XB_TOPGEN   3392
#define XCD_BAR_WORDS 3456
#define XB_SPIN_CAP (1u << 18)
__device__ __forceinline__ unsigned xb_ld(unsigned* p)              { return __hip_atomic_load(p, __ATOMIC_RELAXED, __HIP_MEMORY_SCOPE_AGENT); }
__device__ __forceinline__ unsigned xb_add(unsigned* p, unsigned v) { return __hip_atomic_fetch_add(p, v, __ATOMIC_RELAXED, __HIP_MEMORY_SCOPE_AGENT); }
__device__ __forceinline__ unsigned xb_xcc_id() { return (unsigned)__builtin_amdgcn_s_getreg((3 << 11) | 20) & 0xFu; }
#define XB_SPIN(cond, bar) do { unsigned _sp = 0; while (cond) { __builtin_amdgcn_s_sleep(1); \
    if ((++_sp & 255u) == 0u) { if (xb_ld(&(bar)[XB_TMO])) break; if (_sp > XB_SPIN_CAP) { atomicAdd(&(bar)[XB_TMO], 1u); break; } } } } while (0)
struct XcdBarrier { unsigned* bar; unsigned x; volatile LAS unsigned* st; };
__device__ __forceinline__ XcdBarrier xcd_barrier_post(unsigned* bar, volatile LAS unsigned* st) {
    XcdBarrier b; b.bar = bar; b.x = xb_xcc_id(); b.st = st;
    if (threadIdx.x == 0) (void)xb_add(&bar[XB_XCNT(b.x)], 1u);
    return b;
}
__device__ __forceinline__ void xcd_barrier_complete(unsigned* bar, unsigned x, unsigned& nloc, unsigned& nx) {
    const unsigned G = gridDim.x * gridDim.y * gridDim.z;
    unsigned sum, cnt, mine, sp = 0u;
    for (;;) {
        sum = 0u; cnt = 0u; mine = 0u;
#pragma unroll
        for (unsigned j = 0; j < 16; ++j) { const unsigned c = xb_ld(&bar[XB_XCNT(j)]); sum += c; cnt += (c > 0u) ? 1u : 0u; mine = (j == x) ? c : mine; }
        if (sum == G) break;
        __builtin_amdgcn_s_sleep(1);
        if ((++sp & 255u) == 0u) { if (xb_ld(&bar[XB_TMO])) break; if (sp > XB_SPIN_CAP) { atomicAdd(&bar[XB_TMO], 1u); break; } }
    }
    nloc = mine > 0u ? mine : 1u; nx = cnt > 0u ? cnt : 1u;
}
__device__ __forceinline__ void xcd_barrier(const XcdBarrier& b) {
    asm volatile("s_waitcnt vmcnt(0)" ::: "memory");
    __syncthreads();
    if (threadIdx.x == 0) {
        unsigned* bar = b.bar;
        __builtin_amdgcn_s_waitcnt(0);
        unsigned nloc = b.st[0], nx = b.st[1];
        unsigned bx_ = b.x; asm volatile("" : "+s"(bx_));
        if (nloc == 0u) { xcd_barrier_complete(bar, bx_, nloc, nx); b.st[0] = nloc; b.st[1] = nx; }
        const unsigned old = xb_add(&bar[XB_XSUB(b.x)], 1u);
        const unsigned gen = old / nloc;
        if (old + 1u == (gen + 1u) * nloc) {
            __builtin_amdgcn_fence(__ATOMIC_RELEASE, "agent");
            asm volatile("s_waitcnt vmcnt(0)" ::: "memory");
            const unsigned og = xb_add(&bar[XB_TOP], 1u);
            const unsigned tg = og / nx;
            if (og + 1u == (tg + 1u) * nx) xb_add(&bar[XB_TOPGEN], 1u);
            else XB_SPIN(xb_ld(&bar[XB_TOPGEN]) == tg, bar);
            __builtin_amdgcn_fence(__ATOMIC_ACQUIRE, "agent");
            xb_add(&bar[XB_XGEN(b.x)], 1u);
            asm volatile("s_waitcnt vmcnt(0)" ::: "memory");
        } else {
            XB_SPIN(xb_ld(&bar[XB_XGEN(b.x)]) == gen, bar);
            __builtin_amdgcn_fence(__ATOMIC_ACQUIRE, "agent");
            asm volatile("s_waitcnt vmcnt(0)" ::: "memory");
        }
    }
    __syncthreads();
}

__device__ __forceinline__ void p0_transpose_item(const float* W, int K, int N, bf16_t* WT, LAS float* scr, int item, int lane) {
    const int nblk = N / 32, kb = item / nblk, nb = item % nblk, k0 = 64 * kb, n0 = 32 * nb;
#pragma unroll 8
    for (int i = 0; i < 32; ++i) { const int kk = 2 * i + (lane >> 5); scr[kk * 33 + (lane & 31)] = W[(size_t)(k0 + kk) * N + n0 + (lane & 31)]; }
    LDS_WAIT(); asm volatile("" ::: "memory");
    const int c = lane & 7;
#pragma unroll
    for (int j = 0; j < 4; ++j) { const int n = (lane >> 3) + 8 * j; const LAS float* s = scr + (8 * c) * 33 + n;
        u32x4 o; o.x = cvt_pk_bf16(s[0 * 33], s[1 * 33]); o.y = cvt_pk_bf16(s[2 * 33], s[3 * 33]); o.z = cvt_pk_bf16(s[4 * 33], s[5 * 33]); o.w = cvt_pk_bf16(s[6 * 33], s[7 * 33]);
        *(u32x4*)(WT + (size_t)(n0 + n) * K + k0 + 8 * c) = o; }
    LDS_WAIT(); asm volatile("" ::: "memory");
}
__device__ __forceinline__ void p0_prologue(LAS unsigned char* lds, int vcu, int G, int wave, int lane, const float* x, const float* ngain, const float* w_in, const float* w_sb, const float* w_ret, const float* w_out,
                                            bf16_t* WinT, bf16_t* WsbT, bf16_t* WretT, bf16_t* WoutT, bf16_t* H, f32x2* tab) {
    asm volatile("" : "+v"(lane));
    LAS float* scr = (LAS float*)(lds + wave * 16384);
    const int gw = vcu * NWAVES + wave, NGW = G * NWAVES;
    constexpr int I_IN = (D / 64) * (INC / 32), I_SQ = (D / 64) * (D / 32);
    for (int it = gw; it < I_IN + 3 * I_SQ; it += NGW) {
        int r = it;
        if (r < I_IN) { p0_transpose_item(w_in, D, INC, WinT, scr, r, lane); continue; } r -= I_IN;
        if (r < I_SQ) { p0_transpose_item(w_sb, D, D, WsbT, scr, r, lane); continue; } r -= I_SQ;
        if (r < I_SQ) { p0_transpose_item(w_ret, D, D, WretT, scr, r, lane); continue; } r -= I_SQ;
        p0_transpose_item(w_out, D, D, WoutT, scr, r, lane);
    }
    f32x4 g[4];
#pragma unroll
    for (int j = 0; j < 4; ++j) g[j] = ((const f32x4*)ngain)[64 * j + lane];
    for (int m = gw; m < NTOK; m += NGW) {
        const f32x4* xr = (const f32x4*)(x + (size_t)m * D) + lane;
        f32x4 v[4]; float s = 0.f;
#pragma unroll
        for (int j = 0; j < 4; ++j) { v[j] = xr[64 * j]; s += (v[j][0] * v[j][0] + v[j][1] * v[j][1]) + (v[j][2] * v[j][2] + v[j][3] * v[j][3]); }
        const float rs = 1.0f / sqrtf(wave_sum(s) * (1.0f / D) + EPS);
        u32x2* o = (u32x2*)(H + (size_t)m * D) + lane;
#pragma unroll
        for (int j = 0; j < 4; ++j) { const f32x4 y = v[j] * rs * g[j]; u32x2 w; w.x = cvt_pk_bf16(y[0], y[1]); w.y = cvt_pk_bf16(y[2], y[3]); o[64 * j] = w; }
    }
    for (int e = (vcu * NWAVES + wave) * 64 + lane; e < SEQ * 128; e += G * NWAVES * 64) {
        const int pos = e >> 7, i = e & 127;
        const float angf = (float)pos * INVF[i];
        const double a = (double)angf;
        const double k = __builtin_rint(a * 0.63661977236758134308);
        double r = __builtin_fma(-k, 1.57079632679489655800, a); r = __builtin_fma(-k, 6.12323399573676603587e-17, r);
        const double r2 = r * r;
        double sp = 1.0 / 6227020800.0; sp = sp * r2 - 1.0 / 39916800.0; sp = sp * r2 + 1.0 / 362880.0; sp = sp * r2 - 1.0 / 5040.0; sp = sp * r2 + 1.0 / 120.0; sp = sp * r2 - 1.0 / 6.0; sp = sp * r2 + 1.0;
        const double sn = r * sp;
        double cp = -1.0 / 87178291200.0; cp = cp * r2 + 1.0 / 479001600.0; cp = cp * r2 - 1.0 / 3628800.0; cp = cp * r2 + 1.0 / 40320.0; cp = cp * r2 - 1.0 / 720.0; cp = cp * r2 + 1.0 / 24.0; cp = cp * r2 - 0.5; cp = cp * r2 + 1.0;
        const int q = (int)((long long)k & 3);
        const double c_ = (q == 0) ? cp : (q == 1) ? -sn : (q == 2) ? -cp : sn;
        const double s_ = (q == 0) ? sn : (q == 1) ? cp : (q == 2) ? -sn : -cp;
        { float* tf = (float*)tab + ((size_t)(pos * 32 + (i >> 2)) * 8 + (i & 3)); tf[0] = (float)c_; tf[4] = (float)s_; }
    }
}

namespace sba {
typedef float f32x16 __attribute__((ext_vector_type(16)));
typedef short v4i16_t __attribute__((ext_vector_type(4)));
constexpr int LDS_K = 0, LDS_V = 32768, LDS_O = 65536;
__device__ __forceinline__ int crow(int r, int hi) { return (r & 3) + 8 * (r >> 2) + 4 * hi; }
__device__ __forceinline__ unsigned offK(int row, int ch) { return (unsigned)(ch * 1024 + ((row ^ (ch & 7)) << 4)); }
__device__ __forceinline__ unsigned offV(int row, int ch) { return (unsigned)(256 * row + 16 * (ch ^ (((row & 3) << 2) | ((row >> 2) & 3)))); }

__device__ __forceinline__ void attn_unit(LAS unsigned char* lds, volatile LAS unsigned* flags, const int w, int bl, int h, int qb, bf16_t* QS, const bf16_t* KS, const bf16_t* VS, const bf16_t* GS) {
    const int lane = fresh_lane(), tid = w * 64 + lane, r = lane & 31, hh = lane >> 5;
    const size_t tok0 = (size_t)bl * SEQ;
    const int qpos = 256 * qb + 32 * w + r;
    const int jtop = 4 * qb + 3, jmine = 4 * qb + (w >> 1);
    bf16x8 qf[8];
    { const bf16_t* qp = QS + (tok0 + qpos) * 1024 + h * SBD + 8 * hh;
#pragma unroll
      for (int ks = 0; ks < 8; ++ks) qf[ks] = *(const bf16x8*)(qp + 16 * ks); }
    const int srow = tid >> 4, sch = tid & 15;
    const bf16_t* kg = KS + (tok0 + srow) * 1024 + h * SBD + sch * 8;
    const bf16_t* vg = VS + (tok0 + srow) * 1024 + h * SBD + sch * 8;
    const unsigned kst0 = offK(srow, sch), kst1 = offK(srow + 32, sch), vst0 = offV(srow, sch), vst1 = offV(srow + 32, sch);
    unsigned kb4[4];
#pragma unroll
    for (int i = 0; i < 4; ++i) kb4[i] = (unsigned)(hh * 1024 + ((r ^ (2 * i + hh)) << 4));
    unsigned vb8[4][2];
    { const int blk = (lane >> 4) & 1, q4 = (lane & 15) >> 2, p = lane & 3;
#pragma unroll
      for (int db = 0; db < 4; ++db)
#pragma unroll
          for (int t = 0; t < 2; ++t) vb8[db][t] = offV(8 * t + 4 * hh + q4, 4 * db + 2 * blk + (p >> 1)) + 8 * (p & 1); }
    f32x16 o[4];
#pragma unroll
    for (int db = 0; db < 4; ++db)
#pragma unroll
        for (int i = 0; i < 16; ++i) o[db][i] = 0.f;
    float Rp = 1.0f; bool wdone = false;
    u32x4 kr0, kr1, vr0, vr1;
    { const size_t go = (size_t)(64 * jtop) * 1024;
      kr0 = *(const u32x4*)(kg + go); kr1 = *(const u32x4*)(kg + go + 32 * 1024); vr0 = *(const u32x4*)(vg + go); vr1 = *(const u32x4*)(vg + go + 32 * 1024); }
    int buf = 0, it = 0;
    for (int jt = jtop; ; --jt, buf ^= 1, ++it) {
        LAS unsigned char* Kb = lds + LDS_K + buf * 16384; LAS unsigned char* Vb = lds + LDS_V + buf * 16384;
        *(LAS u32x4*)(Kb + kst0) = kr0; *(LAS u32x4*)(Kb + kst1) = kr1; *(LAS u32x4*)(Vb + vst0) = vr0; *(LAS u32x4*)(Vb + vst1) = vr1;
        if (jt > 0) { const size_t go = (size_t)(64 * (jt - 1)) * 1024;
            kr0 = *(const u32x4*)(kg + go); kr1 = *(const u32x4*)(kg + go + 32 * 1024); vr0 = *(const u32x4*)(vg + go); vr1 = *(const u32x4*)(vg + go + 32 * 1024); }
        if (lane == 0) flags[(it & 1) * 8 + w] = wdone ? 1u : 0u;
        LDS_WAIT(); __builtin_amdgcn_s_barrier(); asm volatile("" ::: "memory");
        { unsigned all = 1u;
#pragma unroll
          for (int i = 0; i < 8; ++i) all &= flags[(it & 1) * 8 + i];
          if (__builtin_amdgcn_readfirstlane(all)) break; }
        if (jt <= jmine && !wdone) {
            f32x16 p0, p1;
#pragma unroll
            for (int i = 0; i < 16; ++i) { p0[i] = 0.f; p1[i] = 0.f; }
#pragma unroll
            for (int ks = 0; ks < 8; ++ks) {
                const bf16x8 k0 = *(const LAS bf16x8*)(Kb + kb4[ks & 3] + 2048 * ks);
                const bf16x8 k1 = *(const LAS bf16x8*)(Kb + kb4[ks & 3] + 2048 * ks + 512);
                p0 = __builtin_amdgcn_mfma_f32_32x32x16_bf16(k0, qf[ks], p0, 0, 0, 0);
                p1 = __builtin_amdgcn_mfma_f32_32x32x16_bf16(k1, qf[ks], p1, 0, 0, 0);
            }
            if (jt >= 4 * qb) {
                const int kbase = 64 * jt + 4 * hh;
#pragma unroll
                for (int i = 0; i < 16; ++i) { const int key = kbase + (i & 3) + 8 * (i >> 2); if (key >= qpos) p0[i] = -INFINITY; if (key + 32 >= qpos) p1[i] = -INFINITY; }
            }
            float wgt[2][16]; float T[2][4], Pz[2][4];
#pragma unroll
            for (int kb = 0; kb < 2; ++kb) {
#pragma unroll
                for (int i = 0; i < 16; ++i) { const float y = kb ? p1[i] : p0[i]; const float kp = __builtin_amdgcn_rcpf(1.0f + __builtin_amdgcn_exp2f(y)); wgt[kb][i] = kp; }
            }
            float c1[2][4], c2[2][4];
#pragma unroll
            for (int kb = 0; kb < 2; ++kb)
#pragma unroll
                for (int g = 0; g < 4; ++g) {
                    c1[kb][g] = wgt[kb][4 * g + 3] * wgt[kb][4 * g + 2]; c2[kb][g] = c1[kb][g] * wgt[kb][4 * g + 1];
                    const float M = c2[kb][g] * wgt[kb][4 * g];
                    const auto rr = __builtin_amdgcn_permlane32_swap(__float_as_uint(M), __float_as_uint(M), false, false);
                    const float mlo = __uint_as_float(rr[0]), mhi = __uint_as_float(rr[1]);
                    T[kb][g] = mlo * mhi; Pz[kb][g] = hh ? 1.0f : mhi;
                }
            float X = Rp;
#pragma unroll
            for (int kb = 1; kb >= 0; --kb)
#pragma unroll
                for (int g = 3; g >= 0; --g) {
                    const float off = X * Pz[kb][g]; X *= T[kb][g];
                    const float k3 = wgt[kb][4 * g + 3], k2 = wgt[kb][4 * g + 2], k1 = wgt[kb][4 * g + 1], k0 = wgt[kb][4 * g];
                    wgt[kb][4 * g + 3] = (1.0f - k3) * off;
                    wgt[kb][4 * g + 2] = (1.0f - k2) * (off * k3);
                    wgt[kb][4 * g + 1] = (1.0f - k1) * (off * c1[kb][g]);
                    wgt[kb][4 * g]     = (1.0f - k0) * (off * c2[kb][g]);
                }
            Rp = X;
            u32x4 pa[4];
#pragma unroll
            for (int s = 0; s < 4; ++s) { const int kb = s >> 1, b8 = 8 * (s & 1);
                pa[s].x = cvt_pk_bf16(wgt[kb][b8], wgt[kb][b8 + 1]); pa[s].y = cvt_pk_bf16(wgt[kb][b8 + 2], wgt[kb][b8 + 3]);
                pa[s].z = cvt_pk_bf16(wgt[kb][b8 + 4], wgt[kb][b8 + 5]); pa[s].w = cvt_pk_bf16(wgt[kb][b8 + 6], wgt[kb][b8 + 7]); }
#pragma unroll
            for (int s = 0; s < 4; ++s)
#pragma unroll
                for (int db = 0; db < 4; ++db) {
                    const v4i16_t lo = __builtin_amdgcn_ds_read_tr16_b64_v4i16((LAS v4i16_t*)(Vb + vb8[db][0] + 4096 * s));
                    const v4i16_t hi = __builtin_amdgcn_ds_read_tr16_b64_v4i16((LAS v4i16_t*)(Vb + vb8[db][1] + 4096 * s));
                    const bf16x8 vf = (bf16x8){lo[0], lo[1], lo[2], lo[3], hi[0], hi[1], hi[2], hi[3]};
                    o[db] = __builtin_amdgcn_mfma_f32_32x32x16_bf16(__builtin_bit_cast(bf16x8, pa[s]), vf, o[db], 0, 0, 0);
                }
            wdone = __all(Rp < 1.17549435e-38f);
        }
        if (jt == 0) break;
    }
    LAS bf16_t* stg = (LAS bf16_t*)(lds + LDS_O + w * 8192);
#pragma unroll
    for (int db = 0; db < 4; ++db)
#pragma unroll
        for (int i = 0; i < 16; ++i) stg[crow(i, hh) * 128 + 32 * db + r] = (bf16_t)(cvt_pk_bf16(o[db][i], 0.f) & 0xffffu);
    LDS_WAIT(); asm volatile("" ::: "memory");
#pragma unroll
    for (int i = 0; i < 8; ++i) {
        const int row = 4 * i + (lane >> 4), ch = lane & 15;
        const u32x4 ov = *(const LAS u32x4*)(stg + row * 128 + ch * 8);
        const size_t go = (tok0 + 256 * qb + 32 * w + row) * 1024 + h * SBD + ch * 8;
        const u32x4 gv = *(const u32x4*)(GS + go);
        u32x4 res;
        res.x = cvt_pk_bf16(bf_lo(ov.x) * bf_lo(gv.x), bf_hi(ov.x) * bf_hi(gv.x)); res.y = cvt_pk_bf16(bf_lo(ov.y) * bf_lo(gv.y), bf_hi(ov.y) * bf_hi(gv.y));
        res.z = cvt_pk_bf16(bf_lo(ov.z) * bf_lo(gv.z), bf_hi(ov.z) * bf_hi(gv.z)); res.w = cvt_pk_bf16(bf_lo(ov.w) * bf_lo(gv.w), bf_hi(ov.w) * bf_hi(gv.w));
        *(u32x4*)(QS + go) = res;
    }
    LDS_WAIT(); __builtin_amdgcn_s_barrier(); asm volatile("" ::: "memory");
}
__device__ __forceinline__ void attn_phase(LAS unsigned char* lds, volatile LAS unsigned* flags, const int w, int G, int bx, bf16_t* QS, const bf16_t* KS, const bf16_t* VS, const bf16_t* GS) {
    for (int u = bx; u < 2 * SBH * 32; u += G) { const int qb = u & 31, bh = u >> 5; attn_unit(lds, flags, w, bh >> 3, bh & 7, qb, QS, KS, VS, GS); }
}
}

__device__ __forceinline__ void naive_attention(int gw, int NGW, int lane, bf16_t* QS, const bf16_t* KS, const bf16_t* VS, const bf16_t* GS) {
    asm volatile("" : "+v"(lane));
    for (int task = gw; task < 2 * SBH * SEQ; task += NGW) {
        const int t = task & (SEQ - 1), bh = task >> 13, h = bh & 7, bl = bh >> 3;
        const size_t rowq = (size_t)(bl * SEQ + t) * 1024 + h * SBD + 2 * lane;
        const unsigned qw = *(const unsigned*)(QS + rowq);
        const float q0 = bf_lo(qw), q1 = bf_hi(qw);
        float a0 = 0.f, a1 = 0.f, run = 0.f;
        const bf16_t* kb = KS + (size_t)(bl * SEQ) * 1024 + h * SBD + 2 * lane;
        const bf16_t* vb = VS + (size_t)(bl * SEQ) * 1024 + h * SBD + 2 * lane;
        for (int s = t - 1; s >= 0; --s) {
            const unsigned kw = *(const unsigned*)(kb + (size_t)s * 1024);
            const unsigned vw = *(const unsigned*)(vb + (size_t)s * 1024);
            const float y = wave_sum(q0 * bf_lo(kw) + q1 * bf_hi(kw));
            const float z = y * LN2F;
            const float sp = fmaxf(z, 0.f) + log1pf(expf(-fabsf(z)));
            const float w = expf((z - sp) + run);
            run -= sp;
            a0 += w * bf_lo(vw); a1 += w * bf_hi(vw);
            if (run < -110.f) break;
        }
        const unsigned gwd = *(const unsigned*)(GS + rowq);
        *(unsigned*)(QS + rowq) = cvt_pk_bf16(a0 * bf_lo(gwd), a1 * bf_hi(gwd));
    }
}
__device__ __forceinline__ void naive_retention(int gw, int NGW, int lane, bf16_t* RQ, const bf16_t* RK, const bf16_t* RV, const bf16_t* GR, const float* rgain) {
    asm volatile("" : "+v"(lane));
    for (int task = gw; task < 2 * RH * SEQ; task += NGW) {
        const int t = task & (SEQ - 1), bh = task >> 13, h = bh & 3, bl = bh >> 2;
        const size_t rowq = (size_t)(bl * SEQ + t) * 1024 + h * RD + 4 * lane;
        const u32x2 qw = *(const u32x2*)(RQ + rowq);
        const float q0 = bf_lo(qw.x), q1 = bf_hi(qw.x), q2 = bf_lo(qw.y), q3 = bf_hi(qw.y);
        float a0 = 0.f, a1 = 0.f, a2 = 0.f, a3 = 0.f;
        const bf16_t* kb = RK + (size_t)(bl * SEQ) * 1024 + h * RD + 4 * lane;
        const bf16_t* vb = RV + (size_t)(bl * SEQ) * 1024 + h * RD + 4 * lane;
        const float l2g = log2gamma(h);
        const int send = (t | 63) + 1;
#pragma unroll 4
        for (int s = 0; s < send; ++s) {
            const u32x2 kw = *(const u32x2*)(kb + (size_t)s * 1024);
            const u32x2 vw = *(const u32x2*)(vb + (size_t)s * 1024);
            const float d = wave_sum((q0 * bf_lo(kw.x) + q1 * bf_hi(kw.x)) + (q2 * bf_lo(kw.y) + q3 * bf_hi(kw.y)));
            const int dist = t > s ? t - s : s - t;
            const float w = d * __builtin_amdgcn_exp2f(l2g * (float)dist);
            a0 += w * bf_lo(vw.x); a1 += w * bf_hi(vw.x); a2 += w * bf_lo(vw.y); a3 += w * bf_hi(vw.y);
        }
        const float ss = wave_sum((a0 * a0 + a1 * a1) + (a2 * a2 + a3 * a3));
        const float rs = 1.0f / sqrtf(ss * (1.0f / RD) + EPS);
        const f32x4 g = *(const f32x4*)(rgain + h * RD + 4 * lane);
        const u32x2 gw2 = *(const u32x2*)(GR + rowq);
        u32x2 o; o.x = cvt_pk_bf16(a0 * rs * g[0] * bf_lo(gw2.x), a1 * rs * g[1] * bf_hi(gw2.x)); o.y = cvt_pk_bf16(a2 * rs * g[2] * bf_lo(gw2.y), a3 * rs * g[3] * bf_hi(gw2.y));
        *(u32x2*)(RQ + rowq) = o;
    }
}

__device__ __forceinline__ bool ph_in(int lo, int hi, int k) { asm volatile("" : "+s"(lo), "+s"(hi)); return lo <= k && k < hi; }
#ifndef PROBE_DUP
#define PROBE_DUP (-1)
#endif
#define REP(k) for (int rep_ = 0; rep_ < ((PROBE_DUP == (k)) ? 2 : 1); ++rep_)
constexpr int NPHASE = 1 + 6 * NPASS;
struct Args { const float* in[10]; float* out; unsigned char* ws; int ph_lo, ph_hi; };
__device__ __forceinline__ unsigned char* lds_ptr(volatile LAS unsigned* tabl, int i) {
    const unsigned lo = __builtin_amdgcn_readfirstlane(tabl[2 * i]), hi = __builtin_amdgcn_readfirstlane(tabl[2 * i + 1]);
    return (unsigned char*)(GAS unsigned char*)(((unsigned long long)hi << 32) | lo);
}
__global__ void __launch_bounds__(NWAVES * 64, 2) fwd(Args args) {
    extern __shared__ __attribute__((aligned(16))) unsigned char lds_raw[];
    LAS unsigned char* lds = (LAS unsigned char*)lds_raw;
    volatile LAS unsigned* MISC = (volatile LAS unsigned*)(lds + MISC_OFF);
    const int tid = threadIdx.x, lane = tid & 63, wave = __builtin_amdgcn_readfirstlane(tid >> 6);
    if (tid < 32) MISC[tid] = 0u;
    if (tid < 12) { const unsigned long long pv = (tid < 10) ? (unsigned long long)args.in[tid] : (tid == 10) ? (unsigned long long)args.out : (unsigned long long)args.ws;
        MISC[32 + 2 * tid] = (unsigned)pv; MISC[32 + 2 * tid + 1] = (unsigned)(pv >> 32); }
    __syncthreads();
    volatile LAS unsigned* PT = MISC + 32;
#define P_IN(i) ((const float*)lds_ptr(PT, (i)))
#define P_OUT() ((float*)lds_ptr(PT, 10))
#define P_WS() (lds_ptr(PT, 11))
    const int lo = args.ph_lo, hi = args.ph_hi;
    const bool use_bar = (hi - lo) > 1;
    XcdBarrier bar; bar.bar = (unsigned*)(args.ws + WS_CTL) + CW_BAR; bar.x = 0; bar.st = MISC + 8;
    if (use_bar) bar = xcd_barrier_post((unsigned*)(args.ws + WS_CTL) + CW_BAR, MISC + 8);
#define IN(k) ph_in(lo, hi, (k))
#define BOTH(k) (IN(k) && IN((k) + 1))
#define GRID_BAR() do { REP(50) xcd_barrier(bar); } while (0)
#define VCU() ((int)((gridDim.x % 8 == 0) ? (blockIdx.x % 8) * (gridDim.x / 8) + blockIdx.x / 8 : blockIdx.x))
    LAS unsigned char* scr = lds + SCR_OFF;

    if (IN(0)) {
        unsigned char* ws = P_WS();
        REP(100) p0_prologue(lds, VCU(), gridDim.x, wave, fresh_lane(), P_IN(0), P_IN(1), P_IN(2), P_IN(7), P_IN(8), P_IN(9),
                    (bf16_t*)(ws + WS_WIN), (bf16_t*)(ws + WS_WSB), (bf16_t*)(ws + WS_WRET), (bf16_t*)(ws + WS_WOUT), (bf16_t*)(ws + WS_H), (f32x2*)(ws + WS_TAB));
        if (BOTH(0)) GRID_BAR();
    }

    _Pragma("unroll") for (int p = 0; p < NPASS; ++p) {
        const int pb = 1 + 6 * p;
        if (IN(pb + 0)) {
            unsigned char* ws = P_WS();
            { const float* qg = P_IN(4); const float* kg = P_IN(5); const float* bm = P_IN(3); LAS float* cst = (LAS float*)(lds + CST_OFF);
              for (int i = wave * 64 + fresh_lane(); i < 2304; i += NWAVES * 64) cst[i] = (i < 128) ? qg[i] : (i < 256) ? kg[i - 128] : bm[i - 256];
              VM_WAIT(); LDS_WAIT(); __syncthreads(); }
            REP(0) {
            { pg8::StaticOrder S1; S1.init(PTOK, 2048, gridDim.x, blockIdx.x, ws + WS_H + (size_t)p * ARR, ws + WS_WIN, D, D, 0);
              EpiQKNorm E1{ws};
              pg8::gemm_phase(lds, scr, wave, D, D, D, S1, E1); }
            { pg8::StaticOrder S2; S2.init(PTOK, INC - 2048, gridDim.x, blockIdx.x, ws + WS_H + (size_t)p * ARR, ws + WS_WIN + (size_t)2048 * D * 2, D, D, 8);
              EpiInProj E{ws, (unsigned char*)P_OUT() + (size_t)p * 2 * ARR, (const f32x2*)(ws + WS_TAB)};
              pg8::gemm_phase(lds, scr, wave, D, D, D, S2, E); }
            }
            if (BOTH(pb + 0)) GRID_BAR();
        }
        if (IN(pb + 1)) {
            unsigned char* ws = P_WS(); unsigned char* dop = (unsigned char*)P_OUT() + (size_t)p * 2 * ARR;
            sba::attn_phase(lds, (volatile LAS unsigned*)scr, wave, gridDim.x, blockIdx.x, (bf16_t*)(ws + WS_QS), (const bf16_t*)(ws + WS_KS), (const bf16_t*)(ws + WS_VS), (const bf16_t*)(ws + WS_GS));
            { RetOrder S{0, (int)gridDim.x, (int)blockIdx.x, (const char*)(ws + WS_A2), (const char*)(ws + WS_B2), (const char*)(dop + DO_KT), (const char*)(ws + WS_RK)};
              EpiU E{(bf16_t*)(dop + DO_U)};
              REP(10) pg8::gemm_phase(lds, scr, wave, 256, 512, 256, S, E); }
            { RetOrder S{1, (int)gridDim.x, (int)blockIdx.x, (const char*)(ws + WS_A2), (const char*)(ws + WS_B2), (const char*)(dop + DO_KT), (const char*)(ws + WS_RK)};
              EpiP E{(bf16_t*)(ws + WS_A2)};
              REP(11) pg8::gemm_phase(lds, scr, wave, 256, 512, 1024, S, E); }
            if (BOTH(pb + 1)) GRID_BAR();
        }
        if (IN(pb + 2)) {
            unsigned char* ws = P_WS(); unsigned char* dop = (unsigned char*)P_OUT() + (size_t)p * 2 * ARR;
            REP(20) ret_scan((int)(blockIdx.x * (NWAVES * 64) + wave * 64 + fresh_lane()), (int)(gridDim.x * NWAVES * 64), (const bf16_t*)(dop + DO_U), (bf16_t*)(ws + WS_B2));
            pg8::StaticOrder S; S.init(PTOK, D, gridDim.x, blockIdx.x, ws + WS_QS, ws + WS_WSB, D, D);
            EpiGate<false> E{(const bf16_t*)(ws + WS_MA), nullptr, (bf16_t*)(ws + WS_T1)};
            REP(2) pg8::gemm_phase(lds, scr, wave, D, D, D, S, E);
            if (BOTH(pb + 2)) GRID_BAR();
        }
        if (IN(pb + 3)) {
            unsigned char* ws = P_WS();
            RetOrder S{2, (int)gridDim.x, (int)blockIdx.x, (const char*)(ws + WS_A2), (const char*)(ws + WS_B2), nullptr, nullptr};
            EpiO E{(bf16_t*)(ws + WS_OB), (const bf16_t*)(ws + WS_GR), P_IN(6)};
            REP(3) pg8::gemm_phase(lds, scr, wave, 512, 512, 512, S, E);
            if (BOTH(pb + 3)) GRID_BAR();
        }
        if (IN(pb + 4)) {
            unsigned char* ws = P_WS();
            pg8::StaticOrder S; S.init(PTOK, D, gridDim.x, blockIdx.x, ws + WS_OB, ws + WS_WRET, D, D);
            EpiGate<true> E{(const bf16_t*)(ws + WS_MB), (const bf16_t*)(ws + WS_T1), (bf16_t*)(ws + WS_MG)};
            REP(4) pg8::gemm_phase(lds, scr, wave, D, D, D, S, E);
            if (BOTH(pb + 4)) GRID_BAR();
        }
        if (IN(pb + 5)) {
            unsigned char* ws = P_WS();
            pg8::StaticOrder S; S.init(PTOK, D, gridDim.x, blockIdx.x, ws + WS_MG, ws + WS_WOUT, D, D);
            EpiOut E{P_IN(0) + (size_t)p * PTOK * D, P_OUT() + (size_t)p * PTOK * D};
            REP(5) pg8::gemm_phase(lds, scr, wave, D, D, D, S, E);
            if (BOTH(pb + 5)) GRID_BAR();
        }
    }
#undef IN
#undef BOTH
#undef GRID_BAR
}

extern "C" void kernel_launch(void* const* d_in, const int* in_sizes, int n_in, void* d_out, int out_size, void* d_ws, size_t ws_size, hipStream_t stream) {
    static int grid = 0;
    if (grid == 0) {
        if (n_in != 10 || in_sizes[0] != NTOK * D || out_size != NTOK * D || ws_size < WS_END) { fprintf(stderr, "kernel_launch: unexpected shapes / workspace (%zu < %zu)\n", ws_size, (size_t)WS_END); grid = -1; return; }
        int dev = 0, cus = 0;
        if (hipGetDevice(&dev) != hipSuccess || hipDeviceGetAttribute(&cus, hipDeviceAttributeMultiprocessorCount, dev) != hipSuccess) { grid = -1; return; }
        if (hipFuncSetAttribute((const void*)fwd, hipFuncAttributeMaxDynamicSharedMemorySize, LDS_BYTES) != hipSuccess) { fprintf(stderr, "kernel_launch: hipFuncSetAttribute failed\n"); grid = -1; return; }
        (void)hipGetLastError();
        grid = cus;
    }
    if (grid < 0) return;
    (void)hipMemsetAsync((char*)d_ws + WS_CTL, 0, CTL_ZERO_BYTES, stream);
    Args a{};
    for (int i = 0; i < 10; ++i) a.in[i] = (const float*)d_in[i];
    a.out = (float*)d_out; a.ws = (unsigned char*)d_ws;
    a.ph_lo = 0; a.ph_hi = NPHASE;
    hipLaunchKernelGGL(fwd, dim3(grid), dim3(NWAVES * 64), LDS_BYTES, stream, a);
}
```
